# Optimizing an MI355X kernel written in HIP

```python
import math
import jax, jax.numpy as jnp
from jax import lax
import numpy as np

D_MODEL = 1024
BATCH = 8
SEQ = 2048
DEPTH = 1
DEC_BATCH = 128
DEC_SEQ = 1
PAST_LEN = 16384
PAGE_SIZE = 128

SSM_WIDTH = D_MODEL // 2
SSM_GROUP = 16
SSM_GROUPS = SSM_WIDTH // SSM_GROUP
SSM_STATE = 64
SGU_WIDTH = D_MODEL // 2
SGU_CHUNK = 128
SGU_HEADS = 4
SGU_HEAD_DIM = SGU_WIDTH // SGU_HEADS
D_FF = 4 * D_MODEL
PLE_DIM = 256
IN_COLS = SSM_WIDTH + 2 * SGU_WIDTH + 2 * D_MODEL
DN_ALPHA = float((2 * DEPTH) ** 0.25)
DN_BETA = float((8 * DEPTH) ** -0.25)
LN_EPS = 1e-5

kernel_name = "s5_gmlp_gated_hybrid_step"


def layer_norm(x, g, b):
    xf = x.astype(jnp.float32)
    mu = jnp.mean(xf, axis=-1, keepdims=True)
    xc = xf - mu
    var = jnp.mean(xc * xc, axis=-1, keepdims=True)
    return (xc * lax.rsqrt(var + LN_EPS) * g.astype(jnp.float32) + b.astype(jnp.float32)).astype(x.dtype)


def _complex_affine_combine(e1, e2):
    a1r, a1i, b1r, b1i = e1
    a2r, a2i, b2r, b2i = e2
    ar = a2r * a1r - a2i * a1i
    ai = a2r * a1i + a2i * a1r
    br = a2r * b1r - a2i * b1i + b2r
    bi = a2r * b1i + a2i * b1r + b2i
    return (ar, ai, br, bi)


def s5_mixer(u, h0_re, h0_im, lam_re, lam_im, log_dt, b_re, b_im, c_re, c_im, d_skip, w_glu, b_glu):
    f32 = jnp.float32
    Bn, L, _ = u.shape
    uf = u.astype(f32)
    ug = uf.reshape(Bn, L, SSM_GROUPS, SSM_GROUP)
    lr = lam_re.astype(f32)
    li = lam_im.astype(f32)
    dt = jnp.exp(log_dt.astype(f32))[:, None]
    mag = jnp.exp(lr * dt)
    ab_re = mag * jnp.cos(li * dt)
    ab_im = mag * jnp.sin(li * dt)
    den = lr * lr + li * li
    nr = ab_re - 1.0
    ni = ab_im
    co_re = (nr * lr + ni * li) / den
    co_im = (ni * lr - nr * li) / den
    br = b_re.astype(f32)
    bi = b_im.astype(f32)
    bb_re = co_re[..., None] * br - co_im[..., None] * bi
    bb_im = co_re[..., None] * bi + co_im[..., None] * br
    bu_re = jnp.einsum('blgc,gpc->lbgp', ug, bb_re)
    bu_im = jnp.einsum('blgc,gpc->lbgp', ug, bb_im)
    a_re_t = jnp.broadcast_to(ab_re[None, None], (L, 1, SSM_GROUPS, SSM_STATE))
    a_im_t = jnp.broadcast_to(ab_im[None, None], (L, 1, SSM_GROUPS, SSM_STATE))
    pw_re, pw_im, h_re, h_im = lax.associative_scan(
        _complex_affine_combine, (a_re_t, a_im_t, bu_re, bu_im), axis=0)
    h0r = h0_re.astype(f32)
    h0i = h0_im.astype(f32)
    h_re, h_im = (h_re + pw_re * h0r - pw_im * h0i,
                  h_im + pw_re * h0i + pw_im * h0r)
    y = (jnp.einsum('lbgp,gcp->blgc', h_re, c_re.astype(f32))
         - jnp.einsum('lbgp,gcp->blgc', h_im, c_im.astype(f32)))
    y = y.reshape(Bn, L, SSM_WIDTH) + d_skip.astype(f32) * uf
    y = jax.nn.gelu(y).astype(u.dtype)
    y = y * jax.nn.sigmoid(y @ w_glu + b_glu)
    return y, h_re[-1], h_im[-1]


def spatial_mix(v, w_s, b_s):
    Bn, L, _ = v.shape
    Lp = -(-L // SGU_CHUNK) * SGU_CHUNK
    vp = jnp.pad(v, ((0, 0), (0, Lp - L), (0, 0)))
    vp = vp.reshape(Bn, Lp // SGU_CHUNK, SGU_CHUNK, SGU_HEADS, SGU_HEAD_DIM)
    mask = jnp.tril(jnp.ones((SGU_CHUNK, SGU_CHUNK), dtype=w_s.dtype))
    s = jnp.einsum('hts,bnshd->bnthd', w_s * mask, vp)
    s = s + jnp.transpose(b_s)[None, None, :, :, None]
    return s.reshape(Bn, Lp, SGU_WIDTH)[:, :L]


def decoder_layer(x, p, h0_re, h0_im, w_in, b_in, lam_re, lam_im, log_dt, b_re, b_im, c_re, c_im,
                  d_skip, w_glu, b_glu, sgu_ln_g, sgu_ln_b, sgu_w, sgu_b, w_branch_a, w_branch_b,
                  w_out, b_out, ln1_g, ln1_b, w_up, b_up, w_down, b_down, w_ple, w_ple_gate,
                  b_ple_gate, ln2_g, ln2_b):
    z = x @ w_in + b_in
    u_a, z_b, gate_a, gate_b = jnp.split(
        z, [SSM_WIDTH, SSM_WIDTH + 2 * SGU_WIDTH, SSM_WIDTH + 2 * SGU_WIDTH + D_MODEL], axis=-1)
    y_a, hT_re, hT_im = s5_mixer(u_a, h0_re, h0_im, lam_re, lam_im, log_dt, b_re, b_im,
                                 c_re, c_im, d_skip, w_glu, b_glu)
    u_b, v_b = jnp.split(jax.nn.gelu(z_b), 2, axis=-1)
    v_b = layer_norm(v_b, sgu_ln_g, sgu_ln_b)
    y_b = u_b * spatial_mix(v_b, sgu_w, sgu_b)
    merged = (jax.nn.sigmoid(gate_a) * (y_a @ w_branch_a)
              + jax.nn.sigmoid(gate_b) * (y_b @ w_branch_b))
    mix = merged @ w_out + b_out
    x1 = layer_norm(DN_ALPHA * x + mix, ln1_g, ln1_b)
    ff = jnp.square(jax.nn.relu(x1 @ w_up + b_up)) @ w_down + b_down
    ple = jax.nn.sigmoid(x1 @ w_ple_gate + b_ple_gate) * (p @ w_ple)
    x2 = layer_norm(DN_ALPHA * x1 + ff + ple, ln2_g, ln2_b)
    return x2, hT_re, hT_im, v_b


def setup_inputs(seed: int = 0) -> dict:
    key = jax.random.key(seed)
    ks = iter(jax.random.split(key, 48))

    def nrm(shape, scale):
        return jax.random.normal(next(ks), shape, jnp.float32) * scale

    G, P, C = SSM_GROUPS, SSM_STATE, SSM_GROUP
    n_idx = jnp.arange(P, dtype=jnp.float32)
    return {
        "x_prompt": nrm((BATCH, SEQ, D_MODEL), 1.0),
        "x_sample": nrm((DEC_BATCH, DEC_SEQ, D_MODEL), 1.0),
        "state_ssm_re": nrm((DEPTH, DEC_BATCH, G, P), 0.5),
        "state_ssm_im": nrm((DEPTH, DEC_BATCH, G, P), 0.5),
        "p_prompt": nrm((DEPTH, BATCH, SEQ, PLE_DIM), 1.0),
        "p_sample": nrm((DEPTH, DEC_BATCH, DEC_SEQ, PLE_DIM), 1.0),
        "w_in": nrm((DEPTH, D_MODEL, IN_COLS), D_MODEL ** -0.5),
        "b_in": nrm((DEPTH, IN_COLS), 0.02),
        "ssm_lambda_re": -0.5 + nrm((DEPTH, G, P), 0.01),
        "ssm_lambda_im": math.pi * n_idx[None, None, :] + nrm((DEPTH, G, P), 0.01),
        "ssm_log_dt": jax.random.uniform(next(ks), (DEPTH, G), jnp.float32,
                                         minval=math.log(1e-3), maxval=math.log(1e-1)),
        "ssm_b_re": nrm((DEPTH, G, P, C), (2 * C) ** -0.5),
        "ssm_b_im": nrm((DEPTH, G, P, C), (2 * C) ** -0.5),
        "ssm_c_re": nrm((DEPTH, G, C, P), (2 * P) ** -0.5),
        "ssm_c_im": nrm((DEPTH, G, C, P), (2 * P) ** -0.5),
        "ssm_d": nrm((DEPTH, SSM_WIDTH), 0.5),
        "w_glu": nrm((DEPTH, SSM_WIDTH, SSM_WIDTH), SSM_WIDTH ** -0.5),
        "b_glu": nrm((DEPTH, SSM_WIDTH), 0.02),
        "sgu_ln_g": 1.0 + nrm((DEPTH, SGU_WIDTH), 0.02),
        "sgu_ln_b": nrm((DEPTH, SGU_WIDTH), 0.02),
        "sgu_w": nrm((DEPTH, SGU_HEADS, SGU_CHUNK, SGU_CHUNK), SGU_CHUNK ** -0.5),
        "sgu_b": 1.0 + nrm((DEPTH, SGU_HEADS, SGU_CHUNK), 0.01),
        "w_branch_a": nrm((DEPTH, SSM_WIDTH, D_MODEL), DN_BETA * SSM_WIDTH ** -0.5),
        "w_branch_b": nrm((DEPTH, SGU_WIDTH, D_MODEL), DN_BETA * SGU_WIDTH ** -0.5),
        "w_out": nrm((DEPTH, D_MODEL, D_MODEL), DN_BETA * D_MODEL ** -0.5),
        "b_out": nrm((DEPTH, D_MODEL), 0.02),
        "ln1_g": 1.0 + nrm((DEPTH, D_MODEL), 0.02),
        "ln1_b": nrm((DEPTH, D_MODEL), 0.02),
        "w_up": nrm((DEPTH, D_MODEL, D_FF), DN_BETA * D_MODEL ** -0.5),
        "b_up": nrm((DEPTH, D_FF), 0.02),
        "w_down": nrm((DEPTH, D_FF, D_MODEL), DN_BETA * D_FF ** -0.5),
        "b_down": nrm((DEPTH, D_MODEL), 0.02),
        "w_ple": nrm((DEPTH, PLE_DIM, D_MODEL), PLE_DIM ** -0.5),
        "w_ple_gate": nrm((DEPTH, D_MODEL, D_MODEL), D_MODEL ** -0.5),
        "b_ple_gate": nrm((DEPTH, D_MODEL), 0.02),
        "ln2_g": 1.0 + nrm((DEPTH, D_MODEL), 0.02),
        "ln2_b": nrm((DEPTH, D_MODEL), 0.02),
    }


def reference(x_prompt, x_sample, state_ssm_re, state_ssm_im, p_prompt, p_sample,
              w_in, b_in, ssm_lambda_re, ssm_lambda_im, ssm_log_dt, ssm_b_re, ssm_b_im,
              ssm_c_re, ssm_c_im, ssm_d, w_glu, b_glu, sgu_ln_g, sgu_ln_b, sgu_w, sgu_b,
              w_branch_a, w_branch_b, w_out, b_out, ln1_g, ln1_b, w_up, b_up, w_down, b_down,
              w_ple, w_ple_gate, b_ple_gate, ln2_g, ln2_b):
    xp = x_prompt
    xs = x_sample
    h0p = jnp.zeros((x_prompt.shape[0], SSM_GROUPS, SSM_STATE), jnp.float32)
    pre_l, pim_l, sre_l, sim_l, sv_l = [], [], [], [], []
    for i in range(DEPTH):
        w = (w_in[i], b_in[i], ssm_lambda_re[i], ssm_lambda_im[i], ssm_log_dt[i], ssm_b_re[i],
             ssm_b_im[i], ssm_c_re[i], ssm_c_im[i], ssm_d[i], w_glu[i], b_glu[i], sgu_ln_g[i],
             sgu_ln_b[i], sgu_w[i], sgu_b[i], w_branch_a[i], w_branch_b[i], w_out[i], b_out[i],
             ln1_g[i], ln1_b[i], w_up[i], b_up[i], w_down[i], b_down[i], w_ple[i],
             w_ple_gate[i], b_ple_gate[i], ln2_g[i], ln2_b[i])
        xp, hpr, hpi, _ = decoder_layer(xp, p_prompt[i], h0p, h0p, *w)
        xs, hsr, hsi, vs = decoder_layer(xs, p_sample[i], state_ssm_re[i], state_ssm_im[i], *w)
        pre_l.append(hpr)
        pim_l.append(hpi)
        sre_l.append(hsr)
        sim_l.append(hsi)
        sv_l.append(vs)
    ssm_re_prompt = jnp.stack(pre_l)
    ssm_im_prompt = jnp.stack(pim_l)
    ssm_re_sample = jnp.stack(sre_l)
    ssm_im_sample = jnp.stack(sim_l)
    sgu_v_sample = jnp.stack(sv_l)
    return (xp, xs, ssm_re_prompt, ssm_im_prompt, ssm_re_sample, ssm_im_sample, sgu_v_sample)
```

```cpp
#include <hip/hip_runtime.h>
#include <hip/hip_cooperative_groups.h>
#include <cstdio>
#include <cstdint>
namespace cg = cooperative_groups;

#define LAS __attribute__((address_space(3)))
typedef unsigned short bf16_t;
typedef short bf16x8 __attribute__((ext_vector_type(8)));
typedef float f32x4 __attribute__((ext_vector_type(4)));
typedef float f32x2 __attribute__((ext_vector_type(2)));
typedef unsigned u32x4 __attribute__((ext_vector_type(4)));
typedef unsigned u32x2 __attribute__((ext_vector_type(2)));

constexpr int DM = 1024, NPT = 16384, NST = 128, T = NPT + NST, SEQ = 2048, NBATCH = 8;
constexpr int SG = 32, SP = 64, SC = 16, TC = 32, NCHUNK = SEQ / TC, NR = NBATCH * NCHUNK, KS5 = TC * SC + 2 * SP;
constexpr int SW = 512, INC = 3584, DFF = 4096, PLE = 256;
constexpr float DN_ALPHA = 1.189207115002721f, LN_EPS = 1e-5f;
constexpr size_t O_Y = 0, O_PRE = (size_t)T * DM, O_PIM = O_PRE + 16384, O_SRE = O_PIM + 16384, O_SIM = O_SRE + 262144, O_SV = O_SIM + 262144;
constexpr size_t MiB = 1u << 20;
constexpr size_t WS_US = 0;
constexpr size_t WS_WIN = 1 * MiB, WS_WUP = 8 * MiB, WS_WDOWN = 16 * MiB, WS_WOUT = 24 * MiB, WS_WPG = 26 * MiB, WS_WPA = 28 * MiB, WS_WPB = 29 * MiB,
                 WS_WGLU = 30 * MiB, WS_WPLE = 30 * MiB + 512 * 1024;
constexpr size_t WS_PL = 31 * MiB;
constexpr size_t WS_XB = 64 * MiB;
constexpr size_t WS_S = 81 * MiB;
constexpr size_t WS_GA = 97 * MiB, WS_GB = 130 * MiB, WS_YAB = 163 * MiB, WS_A2 = 196 * MiB, WS_PB = 216 * MiB;
constexpr size_t WS_HB = 97 * MiB;
constexpr size_t WS_BTS = 226 * MiB, WS_MM = 246 * MiB, WS_END = 250 * MiB;
constexpr int LDS_BYTES = 147456;

__device__ __forceinline__ unsigned cvt_pk_bf16(float lo, float hi) { unsigned r; asm("v_cvt_pk_bf16_f32 %0, %1, %2" : "=v"(r) : "v"(lo), "v"(hi)); return r; }
__device__ __forceinline__ float bf_lo(unsigned w) { return __uint_as_float(w << 16); }
__device__ __forceinline__ float bf_hi(unsigned w) { return __uint_as_float(w & 0xffff0000u); }
__device__ __forceinline__ u32x4 pack8(f32x4 a, f32x4 b) { u32x4 w; w.x = cvt_pk_bf16(a[0], a[1]); w.y = cvt_pk_bf16(a[2], a[3]); w.z = cvt_pk_bf16(b[0], b[1]); w.w = cvt_pk_bf16(b[2], b[3]); return w; }
__device__ __forceinline__ void unpack8(u32x4 w, f32x4& a, f32x4& b) { a = (f32x4){bf_lo(w.x), bf_hi(w.x), bf_lo(w.y), bf_hi(w.y)}; b = (f32x4){bf_lo(w.z), bf_hi(w.z), bf_lo(w.w), bf_hi(w.w)}; }
__device__ __forceinline__ float sigmoidf_(float x) { return __builtin_amdgcn_rcpf(1.0f + __builtin_amdgcn_exp2f(-1.4426950408889634f * x)); }
__device__ __forceinline__ float gelu_tanh(float x) { const float u = 1.5957691216057308f * (x + 0.044715f * x * x * x); return x * sigmoidf_(u); }
__device__ __forceinline__ f32x4 sig4(f32x4 v) { return (f32x4){sigmoidf_(v[0]), sigmoidf_(v[1]), sigmoidf_(v[2]), sigmoidf_(v[3])}; }
__device__ __forceinline__ f32x4 gelu4(f32x4 v) { return (f32x4){gelu_tanh(v[0]), gelu_tanh(v[1]), gelu_tanh(v[2]), gelu_tanh(v[3])}; }
__device__ __forceinline__ float wave_sum(float v) {
#pragma unroll
    for (int o = 1; o < 64; o <<= 1) v += __shfl_xor(v, o);
    return v;
}

namespace pg8 {
constexpr int BM = 256, BK = 64, HALF = 128, HTB = HALF * BK * 2, STAGE_BYTES = 8 * HTB, NXCD = 8, WGM = 8;
__host__ __device__ __forceinline__ int lds_byte(int r, int c) { const int st = (r >> 4) * 2 + (c >> 5), rr = r & 15, cc = c & 31, ob = rr * 64 + cc * 2; return st * 1024 + (ob ^ (((ob >> 9) & 1) << 5)); }
__host__ __device__ __forceinline__ void stage_rc(int b, int& R, int& C) { const int st = b / 1024, sb = b % 1024, swz = sb ^ (((sb >> 9) & 1) << 5); R = (st >> 1) * 16 + swz / 64; C = (st & 1) * 32 + (swz % 64) / 2; }
__host__ __device__ __forceinline__ int perm32(int rho) { const int n = rho >> 4, i = rho & 15; return 8 * (i >> 2) + 4 * n + (i & 3); }

struct Unit { int pm, pn, pb; };
struct Gemm { const bf16_t* A; const bf16_t* Bt; int K, lda, ldb; size_t sA, sB; };

struct Order {
    int nM, nN, nB, nwg, G, c;
    __device__ void init(int nM_, int nN_, int nB_, int G_, int c_) { nM = nM_; nN = nN_; nB = nB_; nwg = (c_ < 0) ? 0 : nM * nN * nB; G = G_; c = (c_ < 0) ? 0 : c_; }
    __device__ bool next(int i, Unit& u) const {
        const long L = (long)i * G + c; if (L >= nwg) return false;
        int wgid = (int)L;
        if (nB > 1) { u.pb = wgid / (nM * nN); const int r = wgid % (nM * nN); u.pm = r / nN; u.pn = r % nN; return true; }
        { const int q = nwg / NXCD, r = nwg % NXCD, xcd = wgid % NXCD, off = wgid / NXCD; wgid = (xcd < r ? xcd * (q + 1) : r * (q + 1) + (xcd - r) * q) + off; }
        const int nig = WGM * nN, gid = wgid / nig, fm = gid * WGM, gsz = (nM - fm) < WGM ? (nM - fm) : WGM;
        u.pm = fm + ((wgid % nig) % gsz); u.pn = (wgid % nig) / gsz; u.pb = 0; return true;
    }
};

template <class Epi, bool ALIGN_EPI, bool SP2>
__device__ __forceinline__ void gemm_phase(LAS unsigned char* lds, const Gemm g, const Order& S, const Epi& E) {
    const int tid = threadIdx.x, wid = __builtin_amdgcn_readfirstlane(tid >> 6), lane = tid & 63, wr = wid >> 2, wc = wid & 3, fr = lane & 15, fq = lane >> 4;
    const int K = g.K, nt = K / BK;
    unsigned voffA[2], voffB[2];
#pragma unroll
    for (int i = 0; i < 2; ++i) { int R, C; stage_rc(tid * 16 + i * 8192, R, C); const int Rb = (R & ~31) + perm32(R & 31);
        voffA[i] = (unsigned)(R * g.lda + C) * 2u; voffB[i] = (unsigned)(Rb * g.ldb + C) * 2u; }
    const size_t kstep = (size_t)(BK * 2);
    const size_t hstepA = (size_t)HALF * g.lda * 2, hstepB = (size_t)HALF * g.ldb * 2;
    const size_t tstepA = 2 * hstepA, tstepB = 2 * hstepB;
    const unsigned ldsw = (unsigned)wid * 1024u;
    const int aoff = lds_byte(wr * 64 + fr, fq * 8), boff = lds_byte(wc * 32 + fr, fq * 8);
#define PG8_SA(b, h) (((b) * 2 + (h)) * HTB)
#define PG8_SB(b, h) ((4 + (b) * 2 + (h)) * HTB)
#define PG8_STAGE(bufoff, gbase, voff) do { _Pragma("unroll") for (int _i = 0; _i < 2; ++_i) \
        __builtin_amdgcn_global_load_lds((const unsigned*)((const char*)(gbase) + (voff)[_i]), (LAS unsigned*)(lds + (bufoff) + ldsw + _i * 8192), 16, 0, 0); } while (0)
#define PG8_LDA(dst, b, h) do { _Pragma("unroll") for (int m = 0; m < 4; ++m) _Pragma("unroll") for (int k = 0; k < 2; ++k) dst[m][k] = *(const LAS bf16x8*)(lds + PG8_SA(b, h) + aoff + m * 2048 + k * 1024); } while (0)
#define PG8_LDB(dst, b, h) do { _Pragma("unroll") for (int n = 0; n < 2; ++n) _Pragma("unroll") for (int k = 0; k < 2; ++k) dst[n][k] = *(const LAS bf16x8*)(lds + PG8_SB(b, h) + boff + n * 2048 + k * 1024); } while (0)
#define PG8_MMA(ai, bj, At, Bt) do { __builtin_amdgcn_s_setprio(1); _Pragma("unroll") for (int m = 0; m < 4; ++m) _Pragma("unroll") for (int n = 0; n < 2; ++n) _Pragma("unroll") for (int k = 0; k < 2; ++k) \
        acc[ai][bj][m][n] = __builtin_amdgcn_mfma_f32_16x16x32_bf16(Bt[n][k], At[m][k], acc[ai][bj][m][n], 0, 0, 0); __builtin_amdgcn_s_setprio(0); } while (0)
#define PG8_WAIT_V(n) asm volatile("s_waitcnt vmcnt(" #n ")" ::: "memory")
#define PG8_WAIT_L(n) asm volatile("s_waitcnt lgkmcnt(" #n ")" ::: "memory")
#define PG8_BAR __builtin_amdgcn_s_barrier()
#define PG8_SCHED __builtin_amdgcn_sched_barrier(0)
    Unit cur, nxt; int ui = 0;
    if (!S.next(0, cur)) return;
    f32x4 acc[2][2][4][2];
#pragma unroll
    for (int a = 0; a < 2; ++a)
#pragma unroll
        for (int b = 0; b < 2; ++b)
#pragma unroll
            for (int m = 0; m < 4; ++m)
#pragma unroll
                for (int n = 0; n < 2; ++n) acc[a][b][m][n] = (f32x4){0.f, 0.f, 0.f, 0.f};
    bf16x8 At[4][2], B0[2][2], B1[2][2];
    const char* cA = (const char*)g.A + (size_t)cur.pb * g.sA + (size_t)cur.pm * tstepA; const char* cB = (const char*)g.Bt + (size_t)cur.pb * g.sB + (size_t)cur.pn * tstepB;
    if constexpr (SP2) {
        PG8_STAGE(PG8_SB(0, 0), cB, voffB); PG8_STAGE(PG8_SB(0, 1), cB + hstepB, voffB); PG8_STAGE(PG8_SA(0, 0), cA, voffA); PG8_STAGE(PG8_SA(0, 1), cA + hstepA, voffA);
        if (wr == 1) PG8_BAR;
        PG8_WAIT_V(2); PG8_BAR;
        PG8_STAGE(PG8_SB(1, 0), cB + kstep, voffB); PG8_STAGE(PG8_SA(1, 0), cA + kstep, voffA); PG8_STAGE(PG8_SB(1, 1), cB + hstepB + kstep, voffB);
        PG8_WAIT_V(6); PG8_BAR;
    } else {
        PG8_STAGE(PG8_SB(0, 0), cB, voffB); PG8_STAGE(PG8_SA(0, 0), cA, voffA); PG8_STAGE(PG8_SB(0, 1), cB + hstepB, voffB); PG8_STAGE(PG8_SA(0, 1), cA + hstepA, voffA);
        if (wr == 1) PG8_BAR;
        PG8_WAIT_V(4); PG8_BAR;
        PG8_STAGE(PG8_SB(1, 0), cB + kstep, voffB); PG8_STAGE(PG8_SA(1, 0), cA + kstep, voffA); PG8_STAGE(PG8_SB(1, 1), cB + hstepB + kstep, voffB);
        PG8_WAIT_V(6); PG8_BAR;
    }
    for (;;) {
        const bool has_next = S.next(ui + 1, nxt);
        const char* nA = has_next ? (const char*)g.A + (size_t)nxt.pb * g.sA + (size_t)nxt.pm * tstepA : cA;
        const char* nB = has_next ? (const char*)g.Bt + (size_t)nxt.pb * g.sB + (size_t)nxt.pn * tstepB : cB;
#pragma unroll 1
        for (int t = 0; t < nt; t += 2) {
            const bool last = (t == nt - 2);
            const char* a1 = cA + (size_t)(t + 1) * kstep;
            const char* a2 = last ? nA : cA + (size_t)(t + 2) * kstep; const char* b2 = last ? nB : cB + (size_t)(t + 2) * kstep;
            const char* a3 = a2 + kstep; const char* b3 = b2 + kstep;
            if constexpr (SP2) {
            PG8_LDB(B0, 0, 0); PG8_LDB(B1, 0, 1); PG8_SCHED; PG8_LDA(At, 0, 0); PG8_STAGE(PG8_SA(1, 1), a1 + hstepA, voffA);
            PG8_WAIT_V(8); PG8_WAIT_L(0); PG8_BAR; PG8_MMA(0, 0, At, B0); PG8_MMA(0, 1, At, B1); PG8_BAR; PG8_SCHED;
            PG8_LDA(At, 0, 1); PG8_STAGE(PG8_SB(0, 0), b2, voffB); PG8_STAGE(PG8_SB(0, 1), b2 + hstepB, voffB); PG8_STAGE(PG8_SA(0, 0), a2, voffA);
            PG8_WAIT_V(8); PG8_WAIT_L(0); PG8_BAR; PG8_MMA(1, 0, At, B0); PG8_MMA(1, 1, At, B1); PG8_BAR; PG8_SCHED;
            PG8_LDB(B0, 1, 0); PG8_LDB(B1, 1, 1); PG8_SCHED; PG8_LDA(At, 1, 0); PG8_STAGE(PG8_SA(0, 1), a2 + hstepA, voffA);
            PG8_WAIT_V(8); PG8_WAIT_L(0); PG8_BAR; PG8_MMA(0, 0, At, B0); PG8_MMA(0, 1, At, B1); PG8_BAR; PG8_SCHED;
            PG8_LDA(At, 1, 1); PG8_STAGE(PG8_SB(1, 0), b3, voffB); PG8_STAGE(PG8_SB(1, 1), b3 + hstepB, voffB); PG8_STAGE(PG8_SA(1, 0), a3, voffA);
            PG8_WAIT_V(8); PG8_WAIT_L(0); PG8_BAR; PG8_MMA(1, 0, At, B0); PG8_MMA(1, 1, At, B1); PG8_BAR; PG8_SCHED;
            } else {
            PG8_LDB(B0, 0, 0); PG8_SCHED; PG8_LDA(At, 0, 0); PG8_STAGE(PG8_SA(1, 1), a1 + hstepA, voffA);
            PG8_WAIT_L(8); PG8_BAR; PG8_WAIT_L(0); PG8_MMA(0, 0, At, B0); PG8_BAR; PG8_SCHED;
            PG8_LDB(B1, 0, 1); PG8_STAGE(PG8_SB(0, 0), b2, voffB);
            PG8_BAR; PG8_WAIT_L(0); PG8_MMA(0, 1, At, B1); PG8_BAR;
            PG8_LDA(At, 0, 1); PG8_STAGE(PG8_SA(0, 0), a2, voffA);
            PG8_BAR; PG8_WAIT_L(0); PG8_MMA(1, 0, At, B0); PG8_BAR; PG8_SCHED;
            PG8_STAGE(PG8_SB(0, 1), b2 + hstepB, voffB);
            PG8_WAIT_V(6); PG8_BAR; PG8_MMA(1, 1, At, B1); PG8_BAR;
            PG8_LDB(B0, 1, 0); PG8_SCHED; PG8_LDA(At, 1, 0); PG8_STAGE(PG8_SA(0, 1), a2 + hstepA, voffA);
            PG8_WAIT_L(8); PG8_BAR; PG8_WAIT_L(0); PG8_MMA(0, 0, At, B0); PG8_BAR; PG8_SCHED;
            PG8_LDB(B1, 1, 1); PG8_STAGE(PG8_SB(1, 0), b3, voffB);
            PG8_BAR; PG8_WAIT_L(0); PG8_MMA(0, 1, At, B1); PG8_BAR;
            PG8_LDA(At, 1, 1); PG8_STAGE(PG8_SA(1, 0), a3, voffA);
            PG8_BAR; PG8_WAIT_L(0); PG8_MMA(1, 0, At, B0); PG8_BAR; PG8_SCHED;
            PG8_STAGE(PG8_SB(1, 1), b3 + hstepB, voffB);
            PG8_WAIT_V(6); PG8_BAR; PG8_MMA(1, 1, At, B1); PG8_BAR;
            }
        }
        if constexpr (ALIGN_EPI) { if (wr == 0) PG8_BAR; }
        {
#define PG8_EPI(MD) do { _Pragma("unroll") for (int ai = 0; ai < 2; ++ai) _Pragma("unroll") for (int m = 0; m < 4; ++m) { const int row = cur.pm * BM + ai * HALF + wr * 64 + m * 16 + fr; \
            _Pragma("unroll") for (int bj = 0; bj < 2; ++bj) E.template ap<MD>(cur.pb, row, cur.pn * BM + bj * HALF + wc * 32 + 8 * fq, acc[ai][bj][m][0], acc[ai][bj][m][1]); \
            asm volatile("" ::: "memory"); } } while (0)
            if constexpr (Epi::NMODE == 1) { PG8_EPI(0); }
            else { const int md = __builtin_amdgcn_readfirstlane(E.mode(cur.pn * BM)); if (md == 0) PG8_EPI(0); else if (md == 1) PG8_EPI(1); else PG8_EPI(2); }
#undef PG8_EPI
        }
        if (!has_next) break;
#pragma unroll
        for (int a = 0; a < 2; ++a)
#pragma unroll
            for (int b = 0; b < 2; ++b)
#pragma unroll
                for (int m = 0; m < 4; ++m)
#pragma unroll
                    for (int n = 0; n < 2; ++n) acc[a][b][m][n] = (f32x4){0.f, 0.f, 0.f, 0.f};
        cur = nxt; cA = nA; cB = nB; ++ui;
        if constexpr (ALIGN_EPI) { if (wr == 1) PG8_BAR; }
    }
    PG8_WAIT_V(0);
    if constexpr (!ALIGN_EPI) { if (wr == 0) PG8_BAR; }
    PG8_BAR;
#undef PG8_SA
#undef PG8_SB
#undef PG8_STAGE
#undef PG8_LDA
#undef PG8_LDB
#undef PG8_MMA
#undef PG8_WAIT_V
#undef PG8_WAIT_L
#undef PG8_BAR
#undef PG8_SCHED
}
}

template <class Epi>
__device__ __forceinline__ void small_gemm(LAS unsigned char* lds, const bf16_t* A, int lda, const bf16_t* Bt, int ldb, int N, int K, int row_base, const Epi& E) {
    const int tid = threadIdx.x, wid = __builtin_amdgcn_readfirstlane(tid >> 6), lane = tid & 63, fr = lane & 15, fq = lane >> 4;
    const int ntile = 8 * (N / 32), kw = K / 8;
    LAS float* red = (LAS float*)lds;
    for (int ti = blockIdx.x; ti < ntile; ti += gridDim.x) {
        const int mt = ti & 7, ntl = ti >> 3;
        f32x4 acc0 = {0.f, 0.f, 0.f, 0.f}, acc1 = {0.f, 0.f, 0.f, 0.f};
        const bf16_t* ap = A + (size_t)(mt * 16 + fr) * lda + wid * kw + 8 * fq;
        const bf16_t* b0 = Bt + (size_t)(ntl * 32 + pg8::perm32(fr)) * ldb + wid * kw + 8 * fq;
        const bf16_t* b1 = Bt + (size_t)(ntl * 32 + pg8::perm32(16 + fr)) * ldb + wid * kw + 8 * fq;
#pragma unroll 4
        for (int k = 0; k < kw; k += 32) {
            const bf16x8 a = *(const bf16x8*)(ap + k), w0 = *(const bf16x8*)(b0 + k), w1 = *(const bf16x8*)(b1 + k);
            acc0 = __builtin_amdgcn_mfma_f32_16x16x32_bf16(w0, a, acc0, 0, 0, 0);
            acc1 = __builtin_amdgcn_mfma_f32_16x16x32_bf16(w1, a, acc1, 0, 0, 0);
        }
        *(LAS f32x4*)(red + (wid * 64 + lane) * 8) = acc0; *(LAS f32x4*)(red + (wid * 64 + lane) * 8 + 4) = acc1;
        __syncthreads();
        if (wid == 0) {
            f32x4 v0 = {0.f, 0.f, 0.f, 0.f}, v1 = {0.f, 0.f, 0.f, 0.f};
#pragma unroll
            for (int w = 0; w < 8; ++w) { v0 += *(LAS f32x4*)(red + (w * 64 + lane) * 8); v1 += *(LAS f32x4*)(red + (w * 64 + lane) * 8 + 4); }
            const int row = row_base + mt * 16 + fr, col = ntl * 32 + 8 * fq;
            if constexpr (Epi::NMODE == 1) E.template ap<0>(0, row, col, v0, v1);
            else { const int md = __builtin_amdgcn_readfirstlane(E.mode(ntl * 32)); if (md == 0) E.template ap<0>(0, row, col, v0, v1); else if (md == 1) E.template ap<1>(0, row, col, v0, v1); else E.template ap<2>(0, row, col, v0, v1); }
        }
        __syncthreads();
    }
}

struct EpiZ {
    static constexpr int NMODE = 3;
    const float* bias; bf16_t *A2, *us, *ub, *vpre, *ga, *gb;
    __device__ __forceinline__ int mode(int col0) const { return col0 < 512 ? 0 : (col0 < 1536 ? 1 : 2); }
    template <int MD> __device__ __forceinline__ void ap(int, int row, int col, f32x4 v0, f32x4 v1) const {
        v0 += *(const f32x4*)(bias + col); v1 += *(const f32x4*)(bias + col + 4);
        bf16_t* dst;
        if constexpr (MD == 0) { dst = (row < NPT) ? A2 + ((size_t)(col >> 4) * NR + (row >> 5)) * KS5 + (row & 31) * 16 + (col & 15) : us + (size_t)(row - NPT) * 512 + col; }
        else if constexpr (MD == 1) { v0 = gelu4(v0); v1 = gelu4(v1); dst = (col < 1024) ? ub + (size_t)row * 512 + (col - 512) : vpre + (size_t)row * 512 + (col - 1024); }
        else { v0 = sig4(v0); v1 = sig4(v1); dst = (col < 2560) ? ga + (size_t)row * 1024 + (col - 1536) : gb + (size_t)row * 1024 + (col - 2560); }
        *(u32x4*)dst = pack8(v0, v1);
    }
};
struct EpiPlain { static constexpr int NMODE = 1; bf16_t* O; int ldc;
    template <int MD> __device__ __forceinline__ void ap(int, int row, int col, f32x4 v0, f32x4 v1) const { *(u32x4*)(O + (size_t)row * ldc + col) = pack8(v0, v1); } };
struct EpiS5 { static constexpr int NMODE = 1; bf16_t* ya;
    template <int MD> __device__ __forceinline__ void ap(int pb, int row, int col, f32x4 v0, f32x4 v1) const {
        *(u32x4*)(ya + ((size_t)row * 32 + (col >> 4)) * 512 + pb * 16 + (col & 15)) = pack8(gelu4(v0), gelu4(v1)); } };
struct EpiGlu { static constexpr int NMODE = 1; const float* bias; const bf16_t* ya; bf16_t* yab;
    template <int MD> __device__ __forceinline__ void ap(int, int row, int col, f32x4 v0, f32x4 v1) const {
        v0 = sig4(v0 + *(const f32x4*)(bias + col)); v1 = sig4(v1 + *(const f32x4*)(bias + col + 4));
        f32x4 y0, y1; unpack8(*(const u32x4*)(ya + (size_t)row * 512 + col), y0, y1);
        *(u32x4*)(yab + (size_t)row * 1024 + col) = pack8(y0 * v0, y1 * v1); } };
struct EpiMergeA { static constexpr int NMODE = 1; const bf16_t* ga; float* tmp;
    template <int MD> __device__ __forceinline__ void ap(int, int row, int col, f32x4 v0, f32x4 v1) const {
        f32x4 g0, g1; unpack8(*(const u32x4*)(ga + (size_t)row * 1024 + col), g0, g1);
        float* o = tmp + (size_t)row * 1024 + col; *(f32x4*)o = g0 * v0; *(f32x4*)(o + 4) = g1 * v1; } };
struct EpiMergeB { static constexpr int NMODE = 1; const bf16_t* gb; const float* tmp; bf16_t* mg;
    template <int MD> __device__ __forceinline__ void ap(int, int row, int col, f32x4 v0, f32x4 v1) const {
        f32x4 g0, g1; unpack8(*(const u32x4*)(gb + (size_t)row * 1024 + col), g0, g1);
        const float* t = tmp + (size_t)row * 1024 + col;
        *(u32x4*)(mg + (size_t)row * 1024 + col) = pack8(*(const f32x4*)t + g0 * v0, *(const f32x4*)(t + 4) + g1 * v1); } };
struct EpiOut { static constexpr int NMODE = 1; const float* bias; const float* xp; const float* xs; float* o;
    template <int MD> __device__ __forceinline__ void ap(int, int row, int col, f32x4 v0, f32x4 v1) const {
        const float* x = (row < NPT) ? xp + (size_t)row * 1024 + col : xs + (size_t)(row - NPT) * 1024 + col;
        float* d = o + (size_t)row * 1024 + col;
        *(f32x4*)d = DN_ALPHA * *(const f32x4*)x + v0 + *(const f32x4*)(bias + col);
        *(f32x4*)(d + 4) = DN_ALPHA * *(const f32x4*)(x + 4) + v1 + *(const f32x4*)(bias + col + 4); } };
struct EpiUp { static constexpr int NMODE = 1; const float* bias; bf16_t* hb;
    template <int MD> __device__ __forceinline__ void ap(int, int row, int col, f32x4 v0, f32x4 v1) const {
        v0 += *(const f32x4*)(bias + col); v1 += *(const f32x4*)(bias + col + 4);
#pragma unroll
        for (int j = 0; j < 4; ++j) { const float a = fmaxf(v0[j], 0.f), b = fmaxf(v1[j], 0.f); v0[j] = a * a; v1[j] = b * b; }
        *(u32x4*)(hb + (size_t)row * DFF + col) = pack8(v0, v1); } };
struct EpiPg { static constexpr int NMODE = 1; const float* bias; bf16_t* pl;
    template <int MD> __device__ __forceinline__ void ap(int, int row, int col, f32x4 v0, f32x4 v1) const {
        v0 = sig4(v0 + *(const f32x4*)(bias + col)); v1 = sig4(v1 + *(const f32x4*)(bias + col + 4));
        u32x4* p = (u32x4*)(pl + (size_t)row * 1024 + col); f32x4 y0, y1; unpack8(*p, y0, y1); *p = pack8(y0 * v0, y1 * v1); } };
struct EpiDown { static constexpr int NMODE = 1; const float* bias; const bf16_t* pg; float* o;
    template <int MD> __device__ __forceinline__ void ap(int, int row, int col, f32x4 v0, f32x4 v1) const {
        f32x4 g0, g1; unpack8(*(const u32x4*)(pg + (size_t)row * 1024 + col), g0, g1);
        float* d = o + (size_t)row * 1024 + col;
        *(f32x4*)d = DN_ALPHA * *(const f32x4*)d + v0 + *(const f32x4*)(bias + col) + g0;
        *(f32x4*)(d + 4) = DN_ALPHA * *(const f32x4*)(d + 4) + v1 + *(const f32x4*)(bias + col + 4) + g1; } };

struct Args { const float* in[37]; float* out; unsigned char* ws; int ph_lo, ph_hi; };

__device__ __forceinline__ void p0_transpose_item(const float* W, int K, int N, bf16_t* WT, LAS float* scr, int item, int lane) {
    const int nblk = N / 32, kb = item / nblk, nb = item % nblk, k0 = 64 * kb, n0 = 32 * nb;
#pragma unroll 8
    for (int i = 0; i < 32; ++i) { const int kk = 2 * i + (lane >> 5); scr[kk * 33 + (lane & 31)] = W[(size_t)(k0 + kk) * N + n0 + (lane & 31)]; }
    asm volatile("s_waitcnt lgkmcnt(0)" ::: "memory");
    const int c = lane & 7;
#pragma unroll
    for (int j = 0; j < 4; ++j) { const int n = (lane >> 3) + 8 * j; const LAS float* s = scr + (8 * c) * 33 + n;
        u32x4 o; o.x = cvt_pk_bf16(s[0 * 33], s[1 * 33]); o.y = cvt_pk_bf16(s[2 * 33], s[3 * 33]); o.z = cvt_pk_bf16(s[4 * 33], s[5 * 33]); o.w = cvt_pk_bf16(s[6 * 33], s[7 * 33]);
        *(u32x4*)(WT + (size_t)(n0 + n) * K + k0 + 8 * c) = o; }
    asm volatile("s_waitcnt lgkmcnt(0)" ::: "memory");
}
__device__ __forceinline__ void cvt_rows(const float* src, bf16_t* dst, size_t n8, size_t i0, size_t stride) {
    for (size_t i = i0; i < n8; i += stride) { const f32x4 a = *(const f32x4*)(src + i * 8), b = *(const f32x4*)(src + i * 8 + 4); *(u32x4*)(dst + i * 8) = pack8(a, b); }
}

__device__ __forceinline__ void ssm_prep_item(const Args& a, LAS float* sc, int g, int j, int lt, bf16_t* BtS, bf16_t* MM) {
    const float* lam_re = a.in[8]; const float* lam_im = a.in[9]; const float* log_dt = a.in[10];
    const float* b_re = a.in[11]; const float* b_im = a.in[12]; const float* c_re = a.in[13]; const float* c_im = a.in[14]; const float* dsk = a.in[15];
    LAS float* X = sc; LAS float* A1 = sc + 128; LAS float* Kt = sc + 256;
    if (lt < 64) {
        const int p = lt; const float dt = expf(log_dt[g]), lr = lam_re[g * 64 + p], li = lam_im[g * 64 + p];
        const float mag = expf(lr * dt), abr = mag * cosf(li * dt), abi = mag * sinf(li * dt);
        const float den = lr * lr + li * li, nr = abr - 1.0f, ni = abi, cor = (nr * lr + ni * li) / den, coi = (ni * lr - nr * li) / den;
        const float mj = expf((float)j * lr * dt), ajr = mj * cosf((float)j * li * dt), aji = mj * sinf((float)j * li * dt);
        X[2 * p] = ajr * cor - aji * coi; X[2 * p + 1] = ajr * coi + aji * cor;
        A1[2 * p] = ajr * abr - aji * abi; A1[2 * p + 1] = ajr * abi + aji * abr;
    }
    __syncthreads();
    {
        const int c = lt >> 4, cp = lt & 15; float s = 0.f;
        for (int p = 0; p < 64; ++p) {
            const float cr = c_re[(g * 16 + c) * 64 + p], ci = c_im[(g * 16 + c) * 64 + p], xr = X[2 * p], xi = X[2 * p + 1];
            const float wr_ = cr * xr - ci * xi, wi_ = cr * xi + ci * xr;
            s += wr_ * b_re[(g * 64 + p) * 16 + cp] - wi_ * b_im[(g * 64 + p) * 16 + cp];
        }
        if (j == 0 && c == cp) s += dsk[g * 16 + c];
        Kt[c * 16 + cp] = s;
    }
    __syncthreads();
    {
        const int q = lt & 31, c = q >> 1, hf = q & 1;
        const LAS float* kr = Kt + c * 16 + hf * 8;
        const u32x4 kv = pack8((f32x4){kr[0], kr[1], kr[2], kr[3]}, (f32x4){kr[4], kr[5], kr[6], kr[7]});
        const u32x4 z = {0u, 0u, 0u, 0u};
        for (int s = lt >> 5; s < 32 - j; s += 8) {
            *(u32x4*)(BtS + ((size_t)g * 512 + (s + j) * 16 + c) * KS5 + s * 16 + hf * 8) = kv;
            if (j >= 1) *(u32x4*)(BtS + ((size_t)g * 512 + s * 16 + c) * KS5 + (s + j) * 16 + hf * 8) = z;
        }
    }
    {
        const int c = lt >> 4, pq = lt & 15; float v[8];
#pragma unroll
        for (int i = 0; i < 4; ++i) { const int p = pq * 4 + i; const float cr = c_re[(g * 16 + c) * 64 + p], ci = c_im[(g * 16 + c) * 64 + p], ar = A1[2 * p], ai = A1[2 * p + 1];
            v[2 * i] = cr * ar - ci * ai; v[2 * i + 1] = -(cr * ai + ci * ar); }
        *(u32x4*)(BtS + ((size_t)g * 512 + j * 16 + c) * KS5 + 512 + 8 * pq) = pack8((f32x4){v[0], v[1], v[2], v[3]}, (f32x4){v[4], v[5], v[6], v[7]});
    }
    {
        const int n = lt >> 1, hf = lt & 1, p = n >> 1, ri = n & 1, s = 31 - j; const float xr = X[2 * p], xi = X[2 * p + 1]; float v[8];
#pragma unroll
        for (int i = 0; i < 8; ++i) { const float br = b_re[(g * 64 + p) * 16 + hf * 8 + i], bi = b_im[(g * 64 + p) * 16 + hf * 8 + i];
            v[i] = ri ? (xr * bi + xi * br) : (xr * br - xi * bi); }
        *(u32x4*)(MM + ((size_t)g * 128 + n) * 512 + s * 16 + hf * 8) = pack8((f32x4){v[0], v[1], v[2], v[3]}, (f32x4){v[4], v[5], v[6], v[7]});
    }
    __syncthreads();
}

__device__ __forceinline__ void ln_row(float* row, const float* gam, const float* bet, bf16_t* obf, int lane) {
    f32x4 v[4]; float s = 0.f;
#pragma unroll
    for (int j = 0; j < 4; ++j) { v[j] = *(const f32x4*)(row + lane * 4 + 256 * j); s += (v[j][0] + v[j][1]) + (v[j][2] + v[j][3]); }
    const float mean = wave_sum(s) * (1.f / 1024.f); float q = 0.f;
#pragma unroll
    for (int j = 0; j < 4; ++j) { v[j] = v[j] - mean; q += (v[j][0] * v[j][0] + v[j][1] * v[j][1]) + (v[j][2] * v[j][2] + v[j][3] * v[j][3]); }
    const float rstd = 1.0f / sqrtf(wave_sum(q) * (1.f / 1024.f) + LN_EPS);
#pragma unroll
    for (int j = 0; j < 4; ++j) { const f32x4 o = v[j] * rstd * *(const f32x4*)(gam + lane * 4 + 256 * j) + *(const f32x4*)(bet + lane * 4 + 256 * j);
        *(f32x4*)(row + lane * 4 + 256 * j) = o;
        if (obf) { u32x2 w; w.x = cvt_pk_bf16(o[0], o[1]); w.y = cvt_pk_bf16(o[2], o[3]); *(u32x2*)(obf + lane * 4 + 256 * j) = w; } }
}

#define WSB(off) ((bf16_t*)(a.ws + (off)))
#define us WSB(WS_US)
#define WinT WSB(WS_WIN)
#define WupT WSB(WS_WUP)
#define WdownT WSB(WS_WDOWN)
#define WoutT WSB(WS_WOUT)
#define WpgT WSB(WS_WPG)
#define WpaT WSB(WS_WPA)
#define WpbT WSB(WS_WPB)
#define WgluT WSB(WS_WGLU)
#define WpleT WSB(WS_WPLE)
#define pl WSB(WS_PL)
#define xb WSB(WS_XB)
#define ya WSB(WS_XB)
#define mg WSB(WS_XB)
#define x1b WSB(WS_XB)
#define Sbuf ((float*)(a.ws + WS_S))
#define ga WSB(WS_GA)
#define gb WSB(WS_GB)
#define yab WSB(WS_YAB)
#define A2 WSB(WS_A2)
#define pb WSB(WS_PB)
#define hb WSB(WS_HB)
#define BtS WSB(WS_BTS)
#define MM WSB(WS_MM)
#define ub ((bf16_t*)a.out)
#define vpre ((bf16_t*)a.out + (size_t)T * 512)
#define ybuf (a.out + O_Y)
__global__ void __launch_bounds__(512, 2) s5_gmlp_fwd(Args a) {
    extern __shared__ __attribute__((aligned(16))) unsigned char lds_raw[];
    LAS unsigned char* lds = (LAS unsigned char*)lds_raw;
    cg::grid_group grid = cg::this_grid();
    const int tid = threadIdx.x, lane = tid & 63, wid = __builtin_amdgcn_readfirstlane(tid >> 6), fr = lane & 15, fq = lane >> 4;
    const int G = gridDim.x, bx = blockIdx.x, gw = bx * 8 + wid, NGW = G * 8;
    const int lo = a.ph_lo, hi = a.ph_hi;
#ifdef PH_ONLY
#define IN(k) ((k) == PH_ONLY && lo <= (k) && (k) < hi)
#else
#define IN(k) (lo <= (k) && (k) < hi)
#endif
#define SEAM(k) do { if (IN(k) && IN((k) + 1)) grid.sync(); } while (0)

    if (IN(0)) {
        {
            LAS float* scr = (LAS float*)(lds + wid * 16384);
            constexpr int I0 = 16 * 112, I1 = 8 * 16, I2 = 8 * 32, I3 = 8 * 32, I4 = 16 * 32, I5 = 16 * 128, I6 = 64 * 32, I7 = 4 * 32, I8 = 16 * 32;
            constexpr int NIT = I0 + I1 + I2 + I3 + I4 + I5 + I6 + I7 + I8;
            for (int it = gw; it < NIT; it += NGW) {
                int r = it;
                if (r < I0) { p0_transpose_item(a.in[6], 1024, INC, WinT, scr, r, lane); continue; } r -= I0;
                if (r < I1) { p0_transpose_item(a.in[16], 512, 512, WgluT, scr, r, lane); continue; } r -= I1;
                if (r < I2) { p0_transpose_item(a.in[22], 512, 1024, WpaT, scr, r, lane); continue; } r -= I2;
                if (r < I3) { p0_transpose_item(a.in[23], 512, 1024, WpbT, scr, r, lane); continue; } r -= I3;
                if (r < I4) { p0_transpose_item(a.in[24], 1024, 1024, WoutT, scr, r, lane); continue; } r -= I4;
                if (r < I5) { p0_transpose_item(a.in[28], 1024, DFF, WupT, scr, r, lane); continue; } r -= I5;
                if (r < I6) { p0_transpose_item(a.in[30], DFF, 1024, WdownT, scr, r, lane); continue; } r -= I6;
                if (r < I7) { p0_transpose_item(a.in[32], PLE, 1024, WpleT, scr, r, lane); continue; } r -= I7;
                p0_transpose_item(a.in[33], 1024, 1024, WpgT, scr, r, lane);
            }
        }
        __syncthreads();
        {
            for (int base = bx * 2; base < 1024; base += G * 2) { const int it = base + (tid >> 8);
                ssm_prep_item(a, (LAS float*)(lds + (tid >> 8) * 4096), it >> 5, it & 31, tid & 255, BtS, MM); }
        }
        {
            const size_t i0 = (size_t)bx * 512 + tid, st = (size_t)G * 512;
            cvt_rows(a.in[0], xb, (size_t)NPT * 1024 / 8, i0, st); cvt_rows(a.in[1], xb + (size_t)NPT * 1024, (size_t)NST * 1024 / 8, i0, st);
            cvt_rows(a.in[4], pb, (size_t)NPT * 256 / 8, i0, st); cvt_rows(a.in[5], pb + (size_t)NPT * 256, (size_t)NST * 256 / 8, i0, st);
        }
    }
    SEAM(0);

    if (IN(1)) {
        EpiZ Ez{a.in[7], A2, us, ub, vpre, ga, gb};
        { pg8::Gemm g{xb, WinT, 1024, 1024, 1024, 0, 0}; pg8::Order S; S.init(64, INC / 256, 1, G, bx); pg8::gemm_phase<EpiZ, true, true>(lds, g, S, Ez); }
        EpiPlain Ep{pl, 1024};
        { pg8::Gemm g{pb, WpleT, 256, 256, 256, 0, 0}; pg8::Order S; const int h = G / 2; S.init(64, 4, 1, h, bx >= h ? bx - h : -1); pg8::gemm_phase<EpiPlain, true, true>(lds, g, S, Ep); }
        __syncthreads();
        small_gemm(lds, xb + (size_t)NPT * 1024, 1024, WinT, 1024, INC, 1024, NPT, Ez);
        small_gemm(lds, pb + (size_t)NPT * 256, 256, WpleT, 256, 1024, 256, NPT, Ep);
    }
    SEAM(1);

    if (IN(2)) {
        const float* lng = a.in[18]; const float* lnb = a.in[19]; const float* sw = a.in[20]; const float* sbias = a.in[21];
        LAS float* st = (LAS float*)lds; LAS bf16_t* vT = (LAS bf16_t*)(lds + 1024);
        for (int un = bx; un < 512; un += G) {
            const int h = un & 3, row0 = (un >> 2) * 128;
            for (int rr = 0; rr < 16; ++rr) { const int r = wid * 16 + rr; f32x4 x0, x1; unpack8(*(const u32x4*)(vpre + (size_t)(row0 + r) * 512 + lane * 8), x0, x1);
                const float mean = wave_sum((x0[0] + x0[1]) + (x0[2] + x0[3]) + (x1[0] + x1[1]) + (x1[2] + x1[3])) * (1.f / 512.f);
                x0 = x0 - mean; x1 = x1 - mean;
                const float var = wave_sum((x0[0] * x0[0] + x0[1] * x0[1]) + (x0[2] * x0[2] + x0[3] * x0[3]) + (x1[0] * x1[0] + x1[1] * x1[1]) + (x1[2] * x1[2] + x1[3] * x1[3])) * (1.f / 512.f);
                if (lane == 0) { st[2 * r] = mean; st[2 * r + 1] = 1.0f / sqrtf(var + LN_EPS); } }
            __syncthreads();
#pragma unroll
            for (int i = 0; i < 2; ++i) { const int idx = tid + i * 512, s = (idx >> 4) * 2, dc = idx & 15, d0 = h * 128 + dc * 8;
                f32x4 x0, x1, y0, y1; unpack8(*(const u32x4*)(vpre + (size_t)(row0 + s) * 512 + d0), x0, x1); unpack8(*(const u32x4*)(vpre + (size_t)(row0 + s + 1) * 512 + d0), y0, y1);
                const float m0 = st[2 * s], r0 = st[2 * s + 1], m1 = st[2 * s + 2], r1 = st[2 * s + 3];
                const f32x4 g0 = *(const f32x4*)(lng + d0), g1 = *(const f32x4*)(lng + d0 + 4), b0 = *(const f32x4*)(lnb + d0), b1 = *(const f32x4*)(lnb + d0 + 4);
                x0 = (x0 - m0) * r0 * g0 + b0; x1 = (x1 - m0) * r0 * g1 + b1; y0 = (y0 - m1) * r1 * g0 + b0; y1 = (y1 - m1) * r1 * g1 + b1;
                LAS unsigned* q = (LAS unsigned*)(vT + (dc * 8) * 136 + s);
#pragma unroll
                for (int j = 0; j < 4; ++j) { q[j * 68] = cvt_pk_bf16(x0[j], y0[j]); q[(4 + j) * 68] = cvt_pk_bf16(x1[j], y1[j]); } }
            __syncthreads();
            f32x4 acc[4][2];
#pragma unroll
            for (int dg = 0; dg < 4; ++dg) { acc[dg][0] = (f32x4){0.f, 0.f, 0.f, 0.f}; acc[dg][1] = (f32x4){0.f, 0.f, 0.f, 0.f}; }
            const int t = wid * 16 + fr, nks = (wid >> 1) + 1;
            for (int ks = 0; ks < nks; ++ks) { const int s0 = ks * 32 + 8 * fq; const float* wp = sw + ((size_t)h * 128 + t) * 128 + s0;
                f32x4 w0 = *(const f32x4*)wp, w1 = *(const f32x4*)(wp + 4);
#pragma unroll
                for (int j = 0; j < 4; ++j) { if (s0 + j > t) w0[j] = 0.f; if (s0 + 4 + j > t) w1[j] = 0.f; }
                const u32x4 wpk = pack8(w0, w1); const bf16x8 wf = __builtin_bit_cast(bf16x8, wpk);
#pragma unroll
                for (int dg = 0; dg < 4; ++dg)
#pragma unroll
                    for (int n = 0; n < 2; ++n) { const bf16x8 vf = *(const LAS bf16x8*)(vT + (dg * 32 + pg8::perm32(16 * n + fr)) * 136 + s0);
                        acc[dg][n] = __builtin_amdgcn_mfma_f32_16x16x32_bf16(vf, wf, acc[dg][n], 0, 0, 0); } }
            { const float bs = sbias[h * 128 + t]; const size_t row = (size_t)row0 + t;
#pragma unroll
              for (int dg = 0; dg < 4; ++dg) { const int d = h * 128 + dg * 32 + 8 * fq; f32x4 u0, u1; unpack8(*(const u32x4*)(ub + row * 512 + d), u0, u1);
                  *(u32x4*)(yab + row * 1024 + 512 + d) = pack8(u0 * (acc[dg][0] + bs), u1 * (acc[dg][1] + bs)); } }
            __syncthreads();
        }
        for (int wt = gw; wt < 4096; wt += NGW) { const int g = wt >> 7, r = wt & 127, mt = r >> 2, ntl = r & 3;
            const bf16_t* ap = A2 + ((size_t)g * NR + mt * 16 + fr) * KS5 + 8 * fq;
            const bf16_t* b0 = MM + ((size_t)g * 128 + ntl * 32 + pg8::perm32(fr)) * 512 + 8 * fq; const bf16_t* b1 = MM + ((size_t)g * 128 + ntl * 32 + pg8::perm32(16 + fr)) * 512 + 8 * fq;
            f32x4 acc0 = {0.f, 0.f, 0.f, 0.f}, acc1 = {0.f, 0.f, 0.f, 0.f};
#pragma unroll 4
            for (int k = 0; k < 512; k += 32) { const bf16x8 av = *(const bf16x8*)(ap + k), w0 = *(const bf16x8*)(b0 + k), w1 = *(const bf16x8*)(b1 + k);
                acc0 = __builtin_amdgcn_mfma_f32_16x16x32_bf16(w0, av, acc0, 0, 0, 0); acc1 = __builtin_amdgcn_mfma_f32_16x16x32_bf16(w1, av, acc1, 0, 0, 0); }
            float* o = Sbuf + ((size_t)(mt * 16 + fr) * 32 + g) * 128 + ntl * 32 + 8 * fq; *(f32x4*)o = acc0; *(f32x4*)(o + 4) = acc1; }
        for (int wt = gw; wt < NST * SG; wt += NGW) { const int b = wt >> 5, g = wt & 31, p = lane;
            const float dt = expf(a.in[10][g]), lr = a.in[8][g * 64 + p], li = a.in[9][g * 64 + p];
            const float mag = expf(lr * dt), abr = mag * cosf(li * dt), abi = mag * sinf(li * dt);
            const float den = lr * lr + li * li, nr = abr - 1.0f, ni = abi, cor = (nr * lr + ni * li) / den, coi = (ni * lr - nr * li) / den;
            f32x4 u0, u1, u2, u3; unpack8(*(const u32x4*)(us + (size_t)b * 512 + g * 16), u0, u1); unpack8(*(const u32x4*)(us + (size_t)b * 512 + g * 16 + 8), u2, u3);
            const float* br = a.in[11] + ((size_t)g * 64 + p) * 16; const float* bi = a.in[12] + ((size_t)g * 64 + p) * 16;
            const f32x4 r0 = *(const f32x4*)br, r1 = *(const f32x4*)(br + 4), r2 = *(const f32x4*)(br + 8), r3 = *(const f32x4*)(br + 12);
            const f32x4 i0 = *(const f32x4*)bi, i1 = *(const f32x4*)(bi + 4), i2 = *(const f32x4*)(bi + 8), i3 = *(const f32x4*)(bi + 12);
            const f32x4 tr = r0 * u0 + r1 * u1 + r2 * u2 + r3 * u3, ti = i0 * u0 + i1 * u1 + i2 * u2 + i3 * u3;
            const float sr = (tr[0] + tr[1]) + (tr[2] + tr[3]), si = (ti[0] + ti[1]) + (ti[2] + ti[3]);
            const float h0r = a.in[2][((size_t)b * 32 + g) * 64 + p], h0i = a.in[3][((size_t)b * 32 + g) * 64 + p];
            const float hr = abr * h0r - abi * h0i + (cor * sr - coi * si), hi_ = abr * h0i + abi * h0r + (cor * si + coi * sr);
            a.out[O_SRE + ((size_t)b * 32 + g) * 64 + p] = hr; a.out[O_SIM + ((size_t)b * 32 + g) * 64 + p] = hi_;
            float yv = 0.f; const float uu[16] = {u0[0], u0[1], u0[2], u0[3], u1[0], u1[1], u1[2], u1[3], u2[0], u2[1], u2[2], u2[3], u3[0], u3[1], u3[2], u3[3]};
#pragma unroll
            for (int c = 0; c < 16; ++c) { const float part = a.in[13][((size_t)g * 16 + c) * 64 + p] * hr - a.in[14][((size_t)g * 16 + c) * 64 + p] * hi_;
                const float tot = wave_sum(part) + a.in[15][g * 16 + c] * uu[c]; yv = (lane == c) ? tot : yv; }
            { const float ge = gelu_tanh(yv), gn = __shfl_down(ge, 1); if (lane < 16 && !(lane & 1)) *(unsigned*)(ya + ((size_t)NPT + b) * 512 + g * 16 + lane) = cvt_pk_bf16(ge, gn); }
        }
        for (int b = gw; b < NST; b += NGW) { const size_t row = (size_t)NPT + b; f32x4 x0, x1; unpack8(*(const u32x4*)(vpre + row * 512 + lane * 8), x0, x1);
            const float mean = wave_sum((x0[0] + x0[1]) + (x0[2] + x0[3]) + (x1[0] + x1[1]) + (x1[2] + x1[3])) * (1.f / 512.f);
            x0 = x0 - mean; x1 = x1 - mean;
            const float var = wave_sum((x0[0] * x0[0] + x0[1] * x0[1]) + (x0[2] * x0[2] + x0[3] * x0[3]) + (x1[0] * x1[0] + x1[1] * x1[1]) + (x1[2] * x1[2] + x1[3] * x1[3])) * (1.f / 512.f);
            const float rstd = 1.0f / sqrtf(var + LN_EPS); const int d0 = lane * 8, h = lane >> 4;
            x0 = x0 * rstd * *(const f32x4*)(lng + d0) + *(const f32x4*)(lnb + d0); x1 = x1 * rstd * *(const f32x4*)(lng + d0 + 4) + *(const f32x4*)(lnb + d0 + 4);
            *(f32x4*)(a.out + O_SV + (size_t)b * 512 + d0) = x0; *(f32x4*)(a.out + O_SV + (size_t)b * 512 + d0 + 4) = x1;
            const float w00 = sw[(size_t)h * 128 * 128], b0 = sbias[h * 128]; f32x4 u0, u1; unpack8(*(const u32x4*)(ub + row * 512 + d0), u0, u1);
            *(u32x4*)(yab + row * 1024 + 512 + d0) = pack8(u0 * (x0 * w00 + b0), u1 * (x1 * w00 + b0)); }
    }
    SEAM(2);

    if (IN(3)) {
        for (int pair = wid * G + bx; pair < NBATCH * SG; pair += 8 * G) { const int b = pair >> 5, g = pair & 31, p = lane;
            const float dt = expf(a.in[10][g]), lr = a.in[8][g * 64 + p], li = a.in[9][g * 64 + p];
            const float m32 = expf(32.f * lr * dt), ar = m32 * cosf(32.f * li * dt), ai = m32 * sinf(32.f * li * dt);
            float hr = 0.f, hi_ = 0.f;
            for (int c0 = 0; c0 < NCHUNK; c0 += 16) { f32x2 sv[16];
#pragma unroll
                for (int i = 0; i < 16; ++i) sv[i] = *(const f32x2*)(Sbuf + ((size_t)(b * NCHUNK + c0 + i) * 32 + g) * 128 + 2 * p);
#pragma unroll
                for (int i = 0; i < 16; ++i) { *(unsigned*)(A2 + ((size_t)g * NR + b * NCHUNK + c0 + i) * KS5 + 512 + 2 * p) = cvt_pk_bf16(hr, hi_);
                    const float nr = ar * hr - ai * hi_ + sv[i][0], ni = ar * hi_ + ai * hr + sv[i][1]; hr = nr; hi_ = ni; } }
            a.out[O_PRE + ((size_t)b * 32 + g) * 64 + p] = hr; a.out[O_PIM + ((size_t)b * 32 + g) * 64 + p] = hi_; }
    }
    SEAM(3);

    if (IN(4)) {
        EpiS5 E{ya};
        pg8::Gemm g{A2, BtS, KS5, KS5, KS5, (size_t)NR * KS5 * 2, (size_t)512 * KS5 * 2}; pg8::Order S; S.init(2, 2, SG, G, bx); pg8::gemm_phase<EpiS5, true, true>(lds, g, S, E);
    }
    SEAM(4);

    if (IN(5)) {
        EpiGlu E{a.in[17], ya, yab};
        { pg8::Gemm g{ya, WgluT, 512, 512, 512, 0, 0}; pg8::Order S; S.init(64, 2, 1, G, bx); pg8::gemm_phase<EpiGlu, true, true>(lds, g, S, E); }
        __syncthreads();
        small_gemm(lds, ya + (size_t)NPT * 512, 512, WgluT, 512, 512, 512, NPT, E);
    }
    SEAM(5);

    if (IN(6)) {
        EpiMergeA Ea{ga, ybuf}; EpiMergeB Eb{gb, ybuf, mg};
        { pg8::Gemm g{yab, WpaT, 512, 1024, 512, 0, 0}; pg8::Order S; S.init(64, 4, 1, G, bx); pg8::gemm_phase<EpiMergeA, true, true>(lds, g, S, Ea); }
        { pg8::Gemm g{yab + 512, WpbT, 512, 1024, 512, 0, 0}; pg8::Order S; S.init(64, 4, 1, G, bx); pg8::gemm_phase<EpiMergeB, true, true>(lds, g, S, Eb); }
        __syncthreads();
        small_gemm(lds, yab + (size_t)NPT * 1024, 1024, WpaT, 512, 1024, 512, NPT, Ea);
        small_gemm(lds, yab + (size_t)NPT * 1024 + 512, 1024, WpbT, 512, 1024, 512, NPT, Eb);
    }
    SEAM(6);

    if (IN(7)) {
        EpiOut E{a.in[25], a.in[0], a.in[1], ybuf};
        { pg8::Gemm g{mg, WoutT, 1024, 1024, 1024, 0, 0}; pg8::Order S; S.init(64, 4, 1, G, bx); pg8::gemm_phase<EpiOut, true, true>(lds, g, S, E); }
        __syncthreads();
        small_gemm(lds, mg + (size_t)NPT * 1024, 1024, WoutT, 1024, 1024, 1024, NPT, E);
    }
    SEAM(7);

    if (IN(8)) { for (int r = gw; r < T; r += NGW) ln_row(ybuf + (size_t)r * 1024, a.in[26], a.in[27], x1b + (size_t)r * 1024, lane); }
    SEAM(8);

    if (IN(9)) {
        EpiUp Eu{a.in[29], hb}; EpiPg Eg{a.in[34], pl};
        { pg8::Gemm g{x1b, WupT, 1024, 1024, 1024, 0, 0}; pg8::Order S; S.init(64, 16, 1, G, bx); pg8::gemm_phase<EpiUp, true, true>(lds, g, S, Eu); }
        { pg8::Gemm g{x1b, WpgT, 1024, 1024, 1024, 0, 0}; pg8::Order S; S.init(64, 4, 1, G, bx); pg8::gemm_phase<EpiPg, true, true>(lds, g, S, Eg); }
        __syncthreads();
        small_gemm(lds, x1b + (size_t)NPT * 1024, 1024, WupT, 1024, DFF, 1024, NPT, Eu);
        small_gemm(lds, x1b + (size_t)NPT * 1024, 1024, WpgT, 1024, 1024, 1024, NPT, Eg);
    }
    SEAM(9);

    if (IN(10)) {
        EpiDown E{a.in[31], pl, ybuf};
        { pg8::Gemm g{hb, WdownT, DFF, DFF, DFF, 0, 0}; pg8::Order S; S.init(64, 4, 1, G, bx); pg8::gemm_phase<EpiDown, true, true>(lds, g, S, E); }
        __syncthreads();
        small_gemm(lds, hb + (size_t)NPT * DFF, DFF, WdownT, DFF, 1024, DFF, NPT, E);
    }
    SEAM(10);

    if (IN(11)) { for (int r = gw; r < T; r += NGW) ln_row(ybuf + (size_t)r * 1024, a.in[35], a.in[36], nullptr, lane); }
#ifdef DBG_K
    grid.sync();
    {   const size_t n = (size_t)T * 1024; const size_t tot = O_SV + 65536;
        for (size_t i = (size_t)bx * 512 + tid; i < tot; i += (size_t)G * 512) { float v = 0.f;
            if (i < n) { DBG_EXPR } a.out[i] = v; } }
#endif
#undef IN
#undef SEAM
}

#undef WSB
#undef us
#undef WinT
#undef WupT
#undef WdownT
#undef WoutT
#undef WpgT
#undef WpaT
#undef WpbT
#undef WgluT
#undef WpleT
#undef pl
#undef xb
#undef ya
#undef mg
#undef x1b
#undef Sbuf
#undef ga
#undef gb
#undef yab
#undef A2
#undef pb
#undef hb
#undef BtS
#undef MM
#undef ub
#undef vpre
#undef ybuf
#ifndef MK_PER_PHASE
#define MK_PER_PHASE 0
#endif
extern "C" void kernel_launch(void* const* d_in, const int* in_sizes, int n_in, void* d_out, int out_size, void* d_ws, size_t ws_size, hipStream_t stream) {
    static int grid = 0;
    if (grid == 0) {
        if (n_in != 37 || ws_size < WS_END) { fprintf(stderr, "kernel_launch: unexpected n_in %d / ws %zu\n", n_in, ws_size); grid = -1; return; }
        int dev = 0, cus = 0, per_cu = 0;
        hipGetDevice(&dev); hipDeviceGetAttribute(&cus, hipDeviceAttributeMultiprocessorCount, dev);
        if (hipFuncSetAttribute((const void*)s5_gmlp_fwd, hipFuncAttributeMaxDynamicSharedMemorySize, LDS_BYTES) != hipSuccess) { fprintf(stderr, "kernel_launch: hipFuncSetAttribute failed\n"); grid = -1; return; }
        if (hipOccupancyMaxActiveBlocksPerMultiprocessor(&per_cu, (const void*)s5_gmlp_fwd, 512, LDS_BYTES) != hipSuccess || per_cu < 1) { fprintf(stderr, "kernel_launch: occupancy query says %d\n", per_cu); per_cu = 1; }
        (void)hipGetLastError();
        grid = cus;
    }
    if (grid < 0) return;
    Args a{};
    for (int i = 0; i < 37; ++i) a.in[i] = (const float*)d_in[i];
    a.out = (float*)d_out; a.ws = (unsigned char*)d_ws;
#if MK_PER_PHASE
    for (int ph = 0; ph < 12; ++ph) { a.ph_lo = ph; a.ph_hi = ph + 1; void* args[] = {&a};
        hipError_t e = hipLaunchCooperativeKernel((const void*)s5_gmlp_fwd, dim3(grid), dim3(512), args, LDS_BYTES, stream);
        if (e != hipSuccess) { fprintf(stderr, "launch failed: %s\n", hipGetErrorString(e)); break; } }
#else
#ifdef DBG_K
    a.ph_lo = 0; a.ph_hi = DBG_K + 1; void* args[] = {&a};
#else
    a.ph_lo = 0; a.ph_hi = 12; void* args[] = {&a};
#endif
    hipError_t e = hipLaunchCooperativeKernel((const void*)s5_gmlp_fwd, dim3(grid), dim3(512), args, LDS_BYTES, stream);
    if (e != hipSuccess) fprintf(stderr, "cooperative launch failed: %s (grid %d)\n", hipGetErrorString(e), grid);
#endif
}
```

```cpp
#include <hip/hip_runtime.h>
#include <hip/hip_cooperative_groups.h>
#include <cstdio>
#include <cstdint>
namespace cg = cooperative_groups;

#define LAS __attribute__((address_space(3)))
typedef unsigned short bf16_t;
typedef short bf16x8 __attribute__((ext_vector_type(8)));
typedef float f32x4 __attribute__((ext_vector_type(4)));
typedef float f32x2 __attribute__((ext_vector_type(2)));
typedef unsigned u32x4 __attribute__((ext_vector_type(4)));
typedef unsigned u32x2 __attribute__((ext_vector_type(2)));

constexpr int DM = 1024, NPT = 16384, NST = 128, T = NPT + NST, SEQ = 2048, NBATCH = 8;
constexpr int SG = 32, SP = 64, SC = 16, TC = 32, NCHUNK = SEQ / TC, NR = NBATCH * NCHUNK, KS5 = TC * SC + 2 * SP;
constexpr int SW = 512, INC = 3584, DFF = 4096, PLE = 256;
constexpr float DN_ALPHA = 1.189207115002721f, LN_EPS = 1e-5f;
constexpr size_t O_Y = 0, O_PRE = (size_t)T * DM, O_PIM = O_PRE + 16384, O_SRE = O_PIM + 16384, O_SIM = O_SRE + 262144, O_SV = O_SIM + 262144;
constexpr size_t MiB = 1u << 20;
constexpr size_t WS_US = 0;
constexpr size_t WS_WIN = 1 * MiB, WS_WUP = 8 * MiB, WS_WDOWN = 16 * MiB, WS_WOUT = 24 * MiB, WS_WPG = 26 * MiB, WS_WPA = 28 * MiB, WS_WPB = 29 * MiB,
                 WS_WGLU = 30 * MiB, WS_WPLE = 30 * MiB + 512 * 1024;
constexpr size_t WS_PL = 31 * MiB;
constexpr size_t WS_XB = 64 * MiB;
constexpr size_t WS_S = 81 * MiB;
constexpr size_t WS_GA = 97 * MiB, WS_GB = 130 * MiB, WS_YAB = 163 * MiB, WS_A2 = 196 * MiB, WS_PB = 216 * MiB;
constexpr size_t WS_HB = 97 * MiB;
constexpr size_t WS_BTS = 226 * MiB, WS_MM = 246 * MiB, WS_END = 250 * MiB;
constexpr size_t WS_BAR = 512 * 1024, BAR_BYTES = 16384;
constexpr int LDS_BYTES = 147456, LDS_BARST = 132096;

__device__ __forceinline__ unsigned cvt_pk_bf16(float lo, float hi) { unsigned r; asm("v_cvt_pk_bf16_f32 %0, %1, %2" : "=v"(r) : "v"(lo), "v"(hi)); return r; }
__device__ __forceinline__ float bf_lo(unsigned w) { return __uint_as_float(w << 16); }
__device__ __forceinline__ float bf_hi(unsigned w) { return __uint_as_float(w & 0xffff0000u); }
__device__ __forceinline__ u32x4 pack8(f32x4 a, f32x4 b) { u32x4 w; w.x = cvt_pk_bf16(a[0], a[1]); w.y = cvt_pk_bf16(a[2], a[3]); w.z = cvt_pk_bf16(b[0], b[1]); w.w = cvt_pk_bf16(b[2], b[3]); return w; }
__device__ __forceinline__ void unpack8(u32x4 w, f32x4& a, f32x4& b) { a = (f32x4){bf_lo(w.x), bf_hi(w.x), bf_lo(w.y), bf_hi(w.y)}; b = (f32x4){bf_lo(w.z), bf_hi(w.z), bf_lo(w.w), bf_hi(w.w)}; }
__device__ __forceinline__ float sigmoidf_(float x) { return __builtin_amdgcn_rcpf(1.0f + __builtin_amdgcn_exp2f(-1.4426950408889634f * x)); }
__device__ __forceinline__ float gelu_tanh(float x) { const float u = 1.5957691216057308f * (x + 0.044715f * x * x * x); return x * sigmoidf_(u); }
__device__ __forceinline__ f32x4 sig4(f32x4 v) { return (f32x4){sigmoidf_(v[0]), sigmoidf_(v[1]), sigmoidf_(v[2]), sigmoidf_(v[3])}; }
__device__ __forceinline__ f32x4 gelu4(f32x4 v) { return (f32x4){gelu_tanh(v[0]), gelu_tanh(v[1]), gelu_tanh(v[2]), gelu_tanh(v[3])}; }
__device__ __forceinline__ float wave_sum(float v) {
#pragma unroll
    for (int o = 1; o < 64; o <<= 1) v += __shfl_xor(v, o);
    return v;
}

namespace pg8 {
constexpr int BM = 256, BK = 64, HALF = 128, HTB = HALF * BK * 2, STAGE_BYTES = 8 * HTB, NXCD = 8, WGM = 8;
__host__ __device__ __forceinline__ int lds_byte(int r, int c) { const int st = (r >> 4) * 2 + (c >> 5), rr = r & 15, cc = c & 31, ob = rr * 64 + cc * 2; return st * 1024 + (ob ^ (((ob >> 9) & 1) << 5)); }
__host__ __device__ __forceinline__ void stage_rc(int b, int& R, int& C) { const int st = b / 1024, sb = b % 1024, swz = sb ^ (((sb >> 9) & 1) << 5); R = (st >> 1) * 16 + swz / 64; C = (st & 1) * 32 + (swz % 64) / 2; }
__host__ __device__ __forceinline__ int perm32(int rho) { const int n = rho >> 4, i = rho & 15; return 8 * (i >> 2) + 4 * n + (i & 3); }

struct Unit { int pm, pn, pb; };
struct Gemm { const bf16_t* A; const bf16_t* Bt; int K, lda, ldb; size_t sA, sB; };

struct Order {
    int nM, nN, nB, nwg, G, c;
    __device__ void init(int nM_, int nN_, int nB_, int G_, int c_) { nM = nM_; nN = nN_; nB = nB_; nwg = (c_ < 0) ? 0 : nM * nN * nB; G = G_; c = (c_ < 0) ? 0 : c_; }
    __device__ bool next(int i, Unit& u) const {
        const long L = (long)i * G + c; if (L >= nwg) return false;
        int wgid = (int)L;
        if (nB > 1) { u.pb = wgid / (nM * nN); const int r = wgid % (nM * nN); u.pm = r / nN; u.pn = r % nN; return true; }
        { const int q = nwg / NXCD, r = nwg % NXCD, xcd = wgid % NXCD, off = wgid / NXCD; wgid = (xcd < r ? xcd * (q + 1) : r * (q + 1) + (xcd - r) * q) + off; }
        const int nig = WGM * nN, gid = wgid / nig, fm = gid * WGM, gsz = (nM - fm) < WGM ? (nM - fm) : WGM;
        u.pm = fm + ((wgid % nig) % gsz); u.pn = (wgid % nig) / gsz; u.pb = 0; return true;
    }
};

template <class Epi, bool ALIGN_EPI, bool SP2>
__device__ __forceinline__ void gemm_phase(LAS unsigned char* lds, const Gemm g, const Order& S, const Epi& E) {
    const int tid = threadIdx.x, wid = __builtin_amdgcn_readfirstlane(tid >> 6), lane = tid & 63, wr = wid >> 2, wc = wid & 3, fr = lane & 15, fq = lane >> 4;
    const int K = g.K, nt = K / BK;
    unsigned voffA[2], voffB[2];
#pragma unroll
    for (int i = 0; i < 2; ++i) { int R, C; stage_rc(tid * 16 + i * 8192, R, C); const int Rb = (R & ~31) + perm32(R & 31);
        voffA[i] = (unsigned)(R * g.lda + C) * 2u; voffB[i] = (unsigned)(Rb * g.ldb + C) * 2u; }
    const size_t kstep = (size_t)(BK * 2);
    const size_t hstepA = (size_t)HALF * g.lda * 2, hstepB = (size_t)HALF * g.ldb * 2;
    const size_t tstepA = 2 * hstepA, tstepB = 2 * hstepB;
    const unsigned ldsw = (unsigned)wid * 1024u;
    const int aoff = lds_byte(wr * 64 + fr, fq * 8), boff = lds_byte(wc * 32 + fr, fq * 8);
#define PG8_SA(b, h) (((b) * 2 + (h)) * HTB)
#define PG8_SB(b, h) ((4 + (b) * 2 + (h)) * HTB)
#define PG8_STAGE(bufoff, gbase, voff) do { _Pragma("unroll") for (int _i = 0; _i < 2; ++_i) \
        __builtin_amdgcn_global_load_lds((const unsigned*)((const char*)(gbase) + (voff)[_i]), (LAS unsigned*)(lds + (bufoff) + ldsw + _i * 8192), 16, 0, 0); } while (0)
#define PG8_LDA(dst, b, h) do { _Pragma("unroll") for (int m = 0; m < 4; ++m) _Pragma("unroll") for (int k = 0; k < 2; ++k) dst[m][k] = *(const LAS bf16x8*)(lds + PG8_SA(b, h) + aoff + m * 2048 + k * 1024); } while (0)
#define PG8_LDB(dst, b, h) do { _Pragma("unroll") for (int n = 0; n < 2; ++n) _Pragma("unroll") for (int k = 0; k < 2; ++k) dst[n][k] = *(const LAS bf16x8*)(lds + PG8_SB(b, h) + boff + n * 2048 + k * 1024); } while (0)
#define PG8_MMA(ai, bj, At, Bt) do { __builtin_amdgcn_s_setprio(1); _Pragma("unroll") for (int m = 0; m < 4; ++m) _Pragma("unroll") for (int n = 0; n < 2; ++n) _Pragma("unroll") for (int k = 0; k < 2; ++k) \
        acc[ai][bj][m][n] = __builtin_amdgcn_mfma_f32_16x16x32_bf16(Bt[n][k], At[m][k], acc[ai][bj][m][n], 0, 0, 0); __builtin_amdgcn_s_setprio(0); } while (0)
#define PG8_WAIT_V(n) asm volatile("s_waitcnt vmcnt(" #n ")" ::: "memory")
#define PG8_WAIT_L(n) asm volatile("s_waitcnt lgkmcnt(" #n ")" ::: "memory")
#define PG8_BAR __builtin_amdgcn_s_barrier()
#define PG8_SCHED __builtin_amdgcn_sched_barrier(0)
    Unit cur, nxt; int ui = 0;
    if (!S.next(0, cur)) return;
    f32x4 acc[2][2][4][2];
#pragma unroll
    for (int a = 0; a < 2; ++a)
#pragma unroll
        for (int b = 0; b < 2; ++b)
#pragma unroll
            for (int m = 0; m < 4; ++m)
#pragma unroll
                for (int n = 0; n < 2; ++n) acc[a][b][m][n] = (f32x4){0.f, 0.f, 0.f, 0.f};
    bf16x8 At[4][2], B0[2][2], B1[2][2];
    const char* cA = (const char*)g.A + (size_t)cur.pb * g.sA + (size_t)cur.pm * tstepA; const char* cB = (const char*)g.Bt + (size_t)cur.pb * g.sB + (size_t)cur.pn * tstepB;
    if constexpr (SP2) {
        PG8_STAGE(PG8_SB(0, 0), cB, voffB); PG8_STAGE(PG8_SB(0, 1), cB + hstepB, voffB); PG8_STAGE(PG8_SA(0, 0), cA, voffA); PG8_STAGE(PG8_SA(0, 1), cA + hstepA, voffA);
        if (wr == 1) PG8_BAR;
        PG8_WAIT_V(2); PG8_BAR;
        PG8_STAGE(PG8_SB(1, 0), cB + kstep, voffB); PG8_STAGE(PG8_SA(1, 0), cA + kstep, voffA); PG8_STAGE(PG8_SB(1, 1), cB + hstepB + kstep, voffB);
        PG8_WAIT_V(6); PG8_BAR;
    } else {
        PG8_STAGE(PG8_SB(0, 0), cB, voffB); PG8_STAGE(PG8_SA(0, 0), cA, voffA); PG8_STAGE(PG8_SB(0, 1), cB + hstepB, voffB); PG8_STAGE(PG8_SA(0, 1), cA + hstepA, voffA);
        if (wr == 1) PG8_BAR;
        PG8_WAIT_V(4); PG8_BAR;
        PG8_STAGE(PG8_SB(1, 0), cB + kstep, voffB); PG8_STAGE(PG8_SA(1, 0), cA + kstep, voffA); PG8_STAGE(PG8_SB(1, 1), cB + hstepB + kstep, voffB);
        PG8_WAIT_V(6); PG8_BAR;
    }
    for (;;) {
        const bool has_next = S.next(ui + 1, nxt);
        const char* nA = has_next ? (const char*)g.A + (size_t)nxt.pb * g.sA + (size_t)nxt.pm * tstepA : cA;
        const char* nB = has_next ? (const char*)g.Bt + (size_t)nxt.pb * g.sB + (size_t)nxt.pn * tstepB : cB;
#pragma unroll 1
        for (int t = 0; t < nt; t += 2) {
            const bool last = (t == nt - 2);
            const char* a1 = cA + (size_t)(t + 1) * kstep;
            const char* a2 = last ? nA : cA + (size_t)(t + 2) * kstep; const char* b2 = last ? nB : cB + (size_t)(t + 2) * kstep;
            const char* a3 = a2 + kstep; const char* b3 = b2 + kstep;
            if constexpr (Epi::MID) { if (t == (nt >> 1)) { int opq = 0; asm volatile("" : "+v"(opq));
#pragma unroll
                for (int ai = 0; ai < 2; ++ai)
#pragma unroll
                    for (int m = 0; m < 4; ++m) { const int row = cur.pm * BM + ai * HALF + wr * 64 + m * 16 + fr + opq;
#pragma unroll
                        for (int bj = 0; bj < 2; ++bj) E.mid(row, cur.pn * BM + bj * HALF + wc * 32 + 8 * fq, acc[ai][bj][m][0], acc[ai][bj][m][1]);
                        asm volatile("" ::: "memory"); } } }
            if constexpr (SP2) {
            PG8_LDB(B0, 0, 0); PG8_LDB(B1, 0, 1); PG8_SCHED; PG8_LDA(At, 0, 0); PG8_STAGE(PG8_SA(1, 1), a1 + hstepA, voffA);
            PG8_WAIT_V(8); PG8_WAIT_L(0); PG8_BAR; PG8_MMA(0, 0, At, B0); PG8_MMA(0, 1, At, B1); PG8_BAR; PG8_SCHED;
            PG8_LDA(At, 0, 1); PG8_STAGE(PG8_SB(0, 0), b2, voffB); PG8_STAGE(PG8_SB(0, 1), b2 + hstepB, voffB); PG8_STAGE(PG8_SA(0, 0), a2, voffA);
            PG8_WAIT_V(8); PG8_WAIT_L(0); PG8_BAR; PG8_MMA(1, 0, At, B0); PG8_MMA(1, 1, At, B1); PG8_BAR; PG8_SCHED;
            PG8_LDB(B0, 1, 0); PG8_LDB(B1, 1, 1); PG8_SCHED; PG8_LDA(At, 1, 0); PG8_STAGE(PG8_SA(0, 1), a2 + hstepA, voffA);
            PG8_WAIT_V(8); PG8_WAIT_L(0); PG8_BAR; PG8_MMA(0, 0, At, B0); PG8_MMA(0, 1, At, B1); PG8_BAR; PG8_SCHED;
            PG8_LDA(At, 1, 1); PG8_STAGE(PG8_SB(1, 0), b3, voffB); PG8_STAGE(PG8_SB(1, 1), b3 + hstepB, voffB); PG8_STAGE(PG8_SA(1, 0), a3, voffA);
            PG8_WAIT_V(8); PG8_WAIT_L(0); PG8_BAR; PG8_MMA(1, 0, At, B0); PG8_MMA(1, 1, At, B1); PG8_BAR; PG8_SCHED;
            } else {
            PG8_LDB(B0, 0, 0); PG8_SCHED; PG8_LDA(At, 0, 0); PG8_STAGE(PG8_SA(1, 1), a1 + hstepA, voffA);
            PG8_WAIT_L(8); PG8_BAR; PG8_WAIT_L(0); PG8_MMA(0, 0, At, B0); PG8_BAR; PG8_SCHED;
            PG8_LDB(B1, 0, 1); PG8_STAGE(PG8_SB(0, 0), b2, voffB);
            PG8_BAR; PG8_WAIT_L(0); PG8_MMA(0, 1, At, B1); PG8_BAR;
            PG8_LDA(At, 0, 1); PG8_STAGE(PG8_SA(0, 0), a2, voffA);
            PG8_BAR; PG8_WAIT_L(0); PG8_MMA(1, 0, At, B0); PG8_BAR; PG8_SCHED;
            PG8_STAGE(PG8_SB(0, 1), b2 + hstepB, voffB);
            PG8_WAIT_V(6); PG8_BAR; PG8_MMA(1, 1, At, B1); PG8_BAR;
            PG8_LDB(B0, 1, 0); PG8_SCHED; PG8_LDA(At, 1, 0); PG8_STAGE(PG8_SA(0, 1), a2 + hstepA, voffA);
            PG8_WAIT_L(8); PG8_BAR; PG8_WAIT_L(0); PG8_MMA(0, 0, At, B0); PG8_BAR; PG8_SCHED;
            PG8_LDB(B1, 1, 1); PG8_STAGE(PG8_SB(1, 0), b3, voffB);
            PG8_BAR; PG8_WAIT_L(0); PG8_MMA(0, 1, At, B1); PG8_BAR;
            PG8_LDA(At, 1, 1); PG8_STAGE(PG8_SA(1, 0), a3, voffA);
            PG8_BAR; PG8_WAIT_L(0); PG8_MMA(1, 0, At, B0); PG8_BAR; PG8_SCHED;
            PG8_STAGE(PG8_SB(1, 1), b3 + hstepB, voffB);
            PG8_WAIT_V(6); PG8_BAR; PG8_MMA(1, 1, At, B1); PG8_BAR;
            }
        }
        if constexpr (ALIGN_EPI) { if (wr == 0) PG8_BAR; }
        {
#define PG8_EPI(MD) do { _Pragma("unroll") for (int ai = 0; ai < 2; ++ai) _Pragma("unroll") for (int m = 0; m < 4; ++m) { const int row = cur.pm * BM + ai * HALF + wr * 64 + m * 16 + fr; \
            _Pragma("unroll") for (int bj = 0; bj < 2; ++bj) E.template ap<MD>(cur.pb, row, cur.pn * BM + bj * HALF + wc * 32 + 8 * fq, acc[ai][bj][m][0], acc[ai][bj][m][1]); \
            asm volatile("" ::: "memory"); } } while (0)
            if constexpr (Epi::NMODE == 1) { PG8_EPI(0); }
            else { const int md = __builtin_amdgcn_readfirstlane(E.mode(cur.pn * BM)); if (md == 0) PG8_EPI(0); else if (md == 1) PG8_EPI(1); else PG8_EPI(2); }
#undef PG8_EPI
        }
        if (!has_next) break;
#pragma unroll
        for (int a = 0; a < 2; ++a)
#pragma unroll
            for (int b = 0; b < 2; ++b)
#pragma unroll
                for (int m = 0; m < 4; ++m)
#pragma unroll
                    for (int n = 0; n < 2; ++n) acc[a][b][m][n] = (f32x4){0.f, 0.f, 0.f, 0.f};
        cur = nxt; cA = nA; cB = nB; ++ui;
        if constexpr (ALIGN_EPI) { if (wr == 1) PG8_BAR; }
    }
    PG8_WAIT_V(0);
    if constexpr (!ALIGN_EPI) { if (wr == 0) PG8_BAR; }
    PG8_BAR;
#undef PG8_SA
#undef PG8_SB
#undef PG8_STAGE
#undef PG8_LDA
#undef PG8_LDB
#undef PG8_MMA
#undef PG8_WAIT_V
#undef PG8_WAIT_L
#undef PG8_BAR
#undef PG8_SCHED
}
}

template <class Epi>
__device__ __forceinline__ void small_gemm(LAS unsigned char* lds, const bf16_t* A, int lda, const bf16_t* Bt, int ldb, int N, int K, int row_base, const Epi& E) {
    const int tid = threadIdx.x, wid = __builtin_amdgcn_readfirstlane(tid >> 6), lane = tid & 63, fr = lane & 15, fq = lane >> 4;
    const int ntile = 8 * (N / 32), kw = K / 8;
    LAS float* red = (LAS float*)lds;
    for (int ti = blockIdx.x; ti < ntile; ti += gridDim.x) {
        const int mt = ti & 7, ntl = ti >> 3;
        f32x4 acc0 = {0.f, 0.f, 0.f, 0.f}, acc1 = {0.f, 0.f, 0.f, 0.f};
        const bf16_t* ap = A + (size_t)(mt * 16 + fr) * lda + wid * kw + 8 * fq;
        const bf16_t* b0 = Bt + (size_t)(ntl * 32 + pg8::perm32(fr)) * ldb + wid * kw + 8 * fq;
        const bf16_t* b1 = Bt + (size_t)(ntl * 32 + pg8::perm32(16 + fr)) * ldb + wid * kw + 8 * fq;
#pragma unroll 4
        for (int k = 0; k < kw; k += 32) {
            const bf16x8 a = *(const bf16x8*)(ap + k), w0 = *(const bf16x8*)(b0 + k), w1 = *(const bf16x8*)(b1 + k);
            acc0 = __builtin_amdgcn_mfma_f32_16x16x32_bf16(w0, a, acc0, 0, 0, 0);
            acc1 = __builtin_amdgcn_mfma_f32_16x16x32_bf16(w1, a, acc1, 0, 0, 0);
        }
        *(LAS f32x4*)(red + (wid * 64 + lane) * 8) = acc0; *(LAS f32x4*)(red + (wid * 64 + lane) * 8 + 4) = acc1;
        __syncthreads();
        if (wid == 0) {
            f32x4 v0 = {0.f, 0.f, 0.f, 0.f}, v1 = {0.f, 0.f, 0.f, 0.f};
            const int row = row_base + mt * 16 + fr, col = ntl * 32 + 8 * fq;
#pragma unroll
            for (int w = 0; w < 8; ++w) { v0 += *(LAS f32x4*)(red + (w * 64 + lane) * 8); v1 += *(LAS f32x4*)(red + (w * 64 + lane) * 8 + 4);
                if constexpr (Epi::MID) { if (w == 3) E.mid(row, col, v0, v1); } }
            if constexpr (Epi::NMODE == 1) E.template ap<0>(0, row, col, v0, v1);
            else { const int md = __builtin_amdgcn_readfirstlane(E.mode(ntl * 32)); if (md == 0) E.template ap<0>(0, row, col, v0, v1); else if (md == 1) E.template ap<1>(0, row, col, v0, v1); else E.template ap<2>(0, row, col, v0, v1); }
        }
        __syncthreads();
    }
}

struct EpiZ {
    static constexpr int NMODE = 3; static constexpr bool MID = false;
    const float* bias; bf16_t *A2, *us, *ub, *vpre, *ga, *gb;
    __device__ __forceinline__ int mode(int col0) const { return col0 < 512 ? 0 : (col0 < 1536 ? 1 : 2); }
    template <int MD> __device__ __forceinline__ void ap(int, int row, int col, f32x4 v0, f32x4 v1) const {
        v0 += *(const f32x4*)(bias + col); v1 += *(const f32x4*)(bias + col + 4);
        bf16_t* dst;
        if constexpr (MD == 0) { dst = (row < NPT) ? A2 + ((size_t)(col >> 4) * NR + (row >> 5)) * KS5 + (row & 31) * 16 + (col & 15) : us + (size_t)(row - NPT) * 512 + col; }
        else if constexpr (MD == 1) { v0 = gelu4(v0); v1 = gelu4(v1); dst = (col < 1024) ? ub + (size_t)row * 512 + (col - 512) : vpre + (size_t)row * 512 + (col - 1024); }
        else { v0 = sig4(v0); v1 = sig4(v1); dst = (col < 2560) ? ga + (size_t)row * 1024 + (col - 1536) : gb + (size_t)row * 1024 + (col - 2560); }
        *(u32x4*)dst = pack8(v0, v1);
    }
};
struct EpiPlain { static constexpr int NMODE = 1; static constexpr bool MID = false; bf16_t* O; int ldc;
    template <int MD> __device__ __forceinline__ void ap(int, int row, int col, f32x4 v0, f32x4 v1) const { *(u32x4*)(O + (size_t)row * ldc + col) = pack8(v0, v1); } };
struct EpiS5 { static constexpr int NMODE = 1; static constexpr bool MID = false; bf16_t* ya;
    template <int MD> __device__ __forceinline__ void ap(int pb, int row, int col, f32x4 v0, f32x4 v1) const {
        *(u32x4*)(ya + ((size_t)row * 32 + (col >> 4)) * 512 + pb * 16 + (col & 15)) = pack8(gelu4(v0), gelu4(v1)); } };
struct EpiGlu { static constexpr int NMODE = 1; static constexpr bool MID = false; const float* bias; const bf16_t* ya; bf16_t* yab;
    template <int MD> __device__ __forceinline__ void ap(int, int row, int col, f32x4 v0, f32x4 v1) const {
        v0 = sig4(v0 + *(const f32x4*)(bias + col)); v1 = sig4(v1 + *(const f32x4*)(bias + col + 4));
        f32x4 y0, y1; unpack8(*(const u32x4*)(ya + (size_t)row * 512 + col), y0, y1);
        *(u32x4*)(yab + (size_t)row * 1024 + col) = pack8(y0 * v0, y1 * v1); } };
struct EpiMergeA { static constexpr int NMODE = 1; static constexpr bool MID = false; const bf16_t* ga; float* tmp;
    template <int MD> __device__ __forceinline__ void ap(int, int row, int col, f32x4 v0, f32x4 v1) const {
        f32x4 g0, g1; unpack8(*(const u32x4*)(ga + (size_t)row * 1024 + col), g0, g1);
        float* o = tmp + (size_t)row * 1024 + col; *(f32x4*)o = g0 * v0; *(f32x4*)(o + 4) = g1 * v1; } };
struct EpiMergeB { static constexpr int NMODE = 1; static constexpr bool MID = false; const bf16_t* gb; const float* tmp; bf16_t* mg;
    template <int MD> __device__ __forceinline__ void ap(int, int row, int col, f32x4 v0, f32x4 v1) const {
        f32x4 g0, g1; unpack8(*(const u32x4*)(gb + (size_t)row * 1024 + col), g0, g1);
        const float* t = tmp + (size_t)row * 1024 + col;
        *(u32x4*)(mg + (size_t)row * 1024 + col) = pack8(*(const f32x4*)t + g0 * v0, *(const f32x4*)(t + 4) + g1 * v1); } };
struct EpiMerge { static constexpr int NMODE = 1; static constexpr bool MID = true; const bf16_t* ga; const bf16_t* gb; bf16_t* mg;
    __device__ __forceinline__ void mid(int row, int col, f32x4& v0, f32x4& v1) const {
        f32x4 a0, a1, b0, b1; unpack8(*(const u32x4*)(ga + (size_t)row * 1024 + col), a0, a1); unpack8(*(const u32x4*)(gb + (size_t)row * 1024 + col), b0, b1);
#pragma unroll
        for (int j = 0; j < 4; ++j) { v0[j] *= a0[j] * __builtin_amdgcn_rcpf(fmaxf(b0[j], 1e-30f)); v1[j] *= a1[j] * __builtin_amdgcn_rcpf(fmaxf(b1[j], 1e-30f)); } }
    template <int MD> __device__ __forceinline__ void ap(int, int row, int col, f32x4 v0, f32x4 v1) const {
        f32x4 b0, b1; unpack8(*(const u32x4*)(gb + (size_t)row * 1024 + col), b0, b1);
        *(u32x4*)(mg + (size_t)row * 1024 + col) = pack8(b0 * v0, b1 * v1); } };
struct EpiOut { static constexpr int NMODE = 1; static constexpr bool MID = false; const float* bias; const float* xp; const float* xs; float* o;
    template <int MD> __device__ __forceinline__ void ap(int, int row, int col, f32x4 v0, f32x4 v1) const {
        const float* x = (row < NPT) ? xp + (size_t)row * 1024 + col : xs + (size_t)(row - NPT) * 1024 + col;
        float* d = o + (size_t)row * 1024 + col;
        *(f32x4*)d = DN_ALPHA * *(const f32x4*)x + v0 + *(const f32x4*)(bias + col);
        *(f32x4*)(d + 4) = DN_ALPHA * *(const f32x4*)(x + 4) + v1 + *(const f32x4*)(bias + col + 4); } };
struct EpiUp { static constexpr int NMODE = 1; static constexpr bool MID = false; const float* bias; bf16_t* hb;
    template <int MD> __device__ __forceinline__ void ap(int, int row, int col, f32x4 v0, f32x4 v1) const {
        v0 += *(const f32x4*)(bias + col); v1 += *(const f32x4*)(bias + col + 4);
#pragma unroll
        for (int j = 0; j < 4; ++j) { const float a = fmaxf(v0[j], 0.f), b = fmaxf(v1[j], 0.f); v0[j] = a * a; v1[j] = b * b; }
        *(u32x4*)(hb + (size_t)row * DFF + col) = pack8(v0, v1); } };
struct EpiPg { static constexpr int NMODE = 1; static constexpr bool MID = false; const float* bias; bf16_t* pl;
    template <int MD> __device__ __forceinline__ void ap(int, int row, int col, f32x4 v0, f32x4 v1) const {
        v0 = sig4(v0 + *(const f32x4*)(bias + col)); v1 = sig4(v1 + *(const f32x4*)(bias + col + 4));
        u32x4* p = (u32x4*)(pl + (size_t)row * 1024 + col); f32x4 y0, y1; unpack8(*p, y0, y1); *p = pack8(y0 * v0, y1 * v1); } };
struct EpiDown { static constexpr int NMODE = 1; static constexpr bool MID = false; const float* bias; const bf16_t* pg; float* o;
    template <int MD> __device__ __forceinline__ void ap(int, int row, int col, f32x4 v0, f32x4 v1) const {
        f32x4 g0, g1; unpack8(*(const u32x4*)(pg + (size_t)row * 1024 + col), g0, g1);
        float* d = o + (size_t)row * 1024 + col;
        *(f32x4*)d = DN_ALPHA * *(const f32x4*)d + v0 + *(const f32x4*)(bias + col) + g0;
        *(f32x4*)(d + 4) = DN_ALPHA * *(const f32x4*)(d + 4) + v1 + *(const f32x4*)(bias + col + 4) + g1; } };

#define XB_TMO      128
#define XB_XCNT(j)  (256  + 64 * (j))
#define XB_XSUB(j)  (1280 + 64 * (j))
#define XB_XGEN(j)  (2304 + 64 * (j))
#define XB_TOP      3328
#define XB_TOPGEN   3392
#define XCD_BAR_WORDS 3456
#define XB_SPIN_CAP (1u << 18)

__device__ __forceinline__ unsigned xb_ld(unsigned* p)              { return __hip_atomic_load(p, __ATOMIC_RELAXED, __HIP_MEMORY_SCOPE_AGENT); }
__device__ __forceinline__ unsigned xb_add(unsigned* p, unsigned v) { return __hip_atomic_fetch_add(p, v, __ATOMIC_RELAXED, __HIP_MEMORY_SCOPE_AGENT); }
__device__ __forceinline__ unsigned xb_xcc_id() { return (unsigned)__builtin_amdgcn_s_getreg((3 << 11) | 20) & 0xFu; }
#define XB_SPIN(cond, bar) do { unsigned _sp = 0; while (cond) { __builtin_amdgcn_s_sleep(1); \
    if ((++_sp & 255u) == 0u) { if (xb_ld(&(bar)[XB_TMO])) break; if (_sp > XB_SPIN_CAP) { atomicAdd(&(bar)[XB_TMO], 1u); break; } } } } while (0)

struct XcdBarrier {
    unsigned* bar; unsigned x;
    volatile LAS unsigned* st;
};

__device__ __forceinline__ XcdBarrier xcd_barrier_post(unsigned* bar, volatile LAS unsigned* st) {
    XcdBarrier b; b.bar = bar; b.x = xb_xcc_id(); b.st = st;
    if (threadIdx.x == 0) (void)xb_add(&bar[XB_XCNT(b.x)], 1u);
    return b;
}
__device__ __forceinline__ void xcd_barrier_complete(unsigned* bar, unsigned x, unsigned& nloc, unsigned& nx) {
    const unsigned G = gridDim.x * gridDim.y * gridDim.z;
    unsigned sum, cnt, mine, sp = 0u;
    for (;;) {
        sum = 0u; cnt = 0u; mine = 0u;
#pragma unroll
        for (unsigned j = 0; j < 16; ++j) { const unsigned c = xb_ld(&bar[XB_XCNT(j)]); sum += c; cnt += (c > 0u) ? 1u : 0u; mine = (j == x) ? c : mine; }
        if (sum == G) break;
        __builtin_amdgcn_s_sleep(1);
        if ((++sp & 255u) == 0u) { if (xb_ld(&bar[XB_TMO])) break; if (sp > XB_SPIN_CAP) { atomicAdd(&bar[XB_TMO], 1u); break; } }
    }
    nloc = mine > 0u ? mine : 1u; nx = cnt > 0u ? cnt : 1u;
}

__device__ __forceinline__ void xcd_barrier(const XcdBarrier& b) {
    asm volatile("s_waitcnt vmcnt(0)" ::: "memory");
    __syncthreads();
    if (threadIdx.x == 0) {
        unsigned* bar = b.bar;
        __builtin_amdgcn_s_waitcnt(0);
        unsigned nloc = b.st[0], nx = b.st[1];
        if (nloc == 0u) { xcd_barrier_complete(bar, b.x, nloc, nx); b.st[0] = nloc; b.st[1] = nx; }
        const unsigned old = xb_add(&bar[XB_XSUB(b.x)], 1u);
        const unsigned gen = old / nloc;
        if (old + 1u == (gen + 1u) * nloc) {
            __builtin_amdgcn_fence(__ATOMIC_RELEASE, "agent");
            asm volatile("s_waitcnt vmcnt(0)" ::: "memory");
            const unsigned og = xb_add(&bar[XB_TOP], 1u);
            const unsigned tg = og / nx;
            if (og + 1u == (tg + 1u) * nx) xb_add(&bar[XB_TOPGEN], 1u);
            else XB_SPIN(xb_ld(&bar[XB_TOPGEN]) == tg, bar);
            __builtin_amdgcn_fence(__ATOMIC_ACQUIRE, "agent");
            xb_add(&bar[XB_XGEN(b.x)], 1u);
            asm volatile("s_waitcnt vmcnt(0)" ::: "memory");
        } else {
            XB_SPIN(xb_ld(&bar[XB_XGEN(b.x)]) == gen, bar);
            __builtin_amdgcn_fence(__ATOMIC_ACQUIRE, "agent");
            asm volatile("s_waitcnt vmcnt(0)" ::: "memory");
        }
    }
    __syncthreads();
}

struct Args { const float* in[37]; float* out; unsigned char* ws; int ph_lo, ph_hi; };

__device__ __forceinline__ void p0_transpose_item(const float* W, int K, int N, bf16_t* WT, LAS float* scr, int item, int lane, int ldw = 0, int koff = 0) {
    if (ldw == 0) ldw = K;
    const int nblk = N / 32, kb = item / nblk, nb = item % nblk, k0 = 64 * kb, n0 = 32 * nb;
#pragma unroll 8
    for (int i = 0; i < 32; ++i) { const int kk = 2 * i + (lane >> 5); scr[kk * 33 + (lane & 31)] = W[(size_t)(k0 + kk) * N + n0 + (lane & 31)]; }
    asm volatile("s_waitcnt lgkmcnt(0)" ::: "memory");
    const int c = lane & 7;
#pragma unroll
    for (int j = 0; j < 4; ++j) { const int n = (lane >> 3) + 8 * j; const LAS float* s = scr + (8 * c) * 33 + n;
        u32x4 o; o.x = cvt_pk_bf16(s[0 * 33], s[1 * 33]); o.y = cvt_pk_bf16(s[2 * 33], s[3 * 33]); o.z = cvt_pk_bf16(s[4 * 33], s[5 * 33]); o.w = cvt_pk_bf16(s[6 * 33], s[7 * 33]);
        *(u32x4*)(WT + (size_t)(n0 + n) * ldw + koff + k0 + 8 * c) = o; }
    asm volatile("s_waitcnt lgkmcnt(0)" ::: "memory");
}
__device__ __forceinline__ void cvt_rows(const float* src, bf16_t* dst, size_t n8, size_t i0, size_t stride) {
    for (size_t i = i0; i < n8; i += stride) { const f32x4 a = *(const f32x4*)(src + i * 8), b = *(const f32x4*)(src + i * 8 + 4); *(u32x4*)(dst + i * 8) = pack8(a, b); }
}

__device__ __forceinline__ void ssm_prep_block(const Args& a, LAS unsigned char* lds, int g, int jg, int tid, bf16_t* BtS, bf16_t* MM) {
    const float* lam_re = a.in[8]; const float* lam_im = a.in[9]; const float* log_dt = a.in[10];
    const float* b_re = a.in[11]; const float* b_im = a.in[12]; const float* c_re = a.in[13]; const float* c_im = a.in[14]; const float* dsk = a.in[15];
    LAS float* Cre = (LAS float*)lds; LAS float* Cim = Cre + 16 * 65; LAS float* Bre = Cim + 16 * 65; LAS float* Bim = Bre + 1024; LAS float* PP = Bim + 1024;
    const int hf2 = tid >> 8, lt = tid & 255;
    LAS float* sc = PP + 512 + hf2 * 1024; LAS float* X = sc; LAS float* A1 = sc + 128; LAS float* Kt = sc + 256;
    for (int i = tid; i < 1024; i += 512) { Cre[(i >> 6) * 65 + (i & 63)] = c_re[g * 1024 + i]; Cim[(i >> 6) * 65 + (i & 63)] = c_im[g * 1024 + i]; Bre[i] = b_re[g * 1024 + i]; Bim[i] = b_im[g * 1024 + i]; }
    if (tid < 64) { const int p = tid; const float dt = expf(log_dt[g]), lr = lam_re[g * 64 + p], li = lam_im[g * 64 + p];
        const float mag = expf(lr * dt), abr = mag * cosf(li * dt), abi = mag * sinf(li * dt);
        const float den = lr * lr + li * li, nr = abr - 1.0f, ni = abi;
        PP[p * 6 + 0] = lr * dt; PP[p * 6 + 1] = li * dt; PP[p * 6 + 2] = abr; PP[p * 6 + 3] = abi; PP[p * 6 + 4] = (nr * lr + ni * li) / den; PP[p * 6 + 5] = (ni * lr - nr * li) / den; }
    __syncthreads();
    for (int it = 0; it < 2; ++it) {
        const int j = jg * 4 + it * 2 + hf2;
        if (lt < 64) { const int p = lt; const float fj = (float)j, mj = expf(fj * PP[p * 6]), ajr = mj * cosf(fj * PP[p * 6 + 1]), aji = mj * sinf(fj * PP[p * 6 + 1]);
            const float abr = PP[p * 6 + 2], abi = PP[p * 6 + 3], cor = PP[p * 6 + 4], coi = PP[p * 6 + 5];
            X[2 * p] = ajr * cor - aji * coi; X[2 * p + 1] = ajr * coi + aji * cor; A1[2 * p] = ajr * abr - aji * abi; A1[2 * p + 1] = ajr * abi + aji * abr; }
        __syncthreads();
        {   const int c = lt >> 4, cp = lt & 15; float s = 0.f;
#pragma unroll 8
            for (int p = 0; p < 64; ++p) { const float cr = Cre[c * 65 + p], ci = Cim[c * 65 + p], xr = X[2 * p], xi = X[2 * p + 1];
                s += (cr * xr - ci * xi) * Bre[p * 16 + cp] - (cr * xi + ci * xr) * Bim[p * 16 + cp]; }
            if (j == 0 && c == cp) s += dsk[g * 16 + c];
            Kt[c * 16 + cp] = s; }
        __syncthreads();
        {   const int q = lt & 31, c = q >> 1, hf = q & 1; const LAS float* kr = Kt + c * 16 + hf * 8;
            const u32x4 kv = pack8((f32x4){kr[0], kr[1], kr[2], kr[3]}, (f32x4){kr[4], kr[5], kr[6], kr[7]}); const u32x4 z = {0u, 0u, 0u, 0u};
            for (int s = lt >> 5; s < 32 - j; s += 8) {
                *(u32x4*)(BtS + ((size_t)g * 512 + (s + j) * 16 + c) * KS5 + s * 16 + hf * 8) = kv;
                if (j >= 1) *(u32x4*)(BtS + ((size_t)g * 512 + s * 16 + c) * KS5 + (s + j) * 16 + hf * 8) = z; } }
        {   const int c = lt >> 4, pq = lt & 15; float v[8];
#pragma unroll
            for (int i = 0; i < 4; ++i) { const int p = pq * 4 + i; const float cr = Cre[c * 65 + p], ci = Cim[c * 65 + p], ar = A1[2 * p], ai = A1[2 * p + 1];
                v[2 * i] = cr * ar - ci * ai; v[2 * i + 1] = -(cr * ai + ci * ar); }
            *(u32x4*)(BtS + ((size_t)g * 512 + j * 16 + c) * KS5 + 512 + 8 * pq) = pack8((f32x4){v[0], v[1], v[2], v[3]}, (f32x4){v[4], v[5], v[6], v[7]}); }
        {   const int n = lt >> 1, hf = lt & 1, p = n >> 1, ri = n & 1, s = 31 - j; const float xr = X[2 * p], xi = X[2 * p + 1]; float v[8];
#pragma unroll
            for (int i = 0; i < 8; ++i) { const float br = Bre[p * 16 + hf * 8 + i], bi = Bim[p * 16 + hf * 8 + i]; v[i] = ri ? (xr * bi + xi * br) : (xr * br - xi * bi); }
            *(u32x4*)(MM + ((size_t)g * 128 + n) * 512 + s * 16 + hf * 8) = pack8((f32x4){v[0], v[1], v[2], v[3]}, (f32x4){v[4], v[5], v[6], v[7]}); }
        __syncthreads();
    }
}

__device__ __forceinline__ void ln_row(float* row, const float* gam, const float* bet, bf16_t* obf, int lane) {
    f32x4 v[4]; float s = 0.f;
#pragma unroll
    for (int j = 0; j < 4; ++j) { v[j] = *(const f32x4*)(row + lane * 4 + 256 * j); s += (v[j][0] + v[j][1]) + (v[j][2] + v[j][3]); }
    const float mean = wave_sum(s) * (1.f / 1024.f); float q = 0.f;
#pragma unroll
    for (int j = 0; j < 4; ++j) { v[j] = v[j] - mean; q += (v[j][0] * v[j][0] + v[j][1] * v[j][1]) + (v[j][2] * v[j][2] + v[j][3] * v[j][3]); }
    const float rstd = 1.0f / sqrtf(wave_sum(q) * (1.f / 1024.f) + LN_EPS);
#pragma unroll
    for (int j = 0; j < 4; ++j) { const f32x4 o = v[j] * rstd * *(const f32x4*)(gam + lane * 4 + 256 * j) + *(const f32x4*)(bet + lane * 4 + 256 * j);
        *(f32x4*)(row + lane * 4 + 256 * j) = o;
        if (obf) { u32x2 w; w.x = cvt_pk_bf16(o[0], o[1]); w.y = cvt_pk_bf16(o[2], o[3]); *(u32x2*)(obf + lane * 4 + 256 * j) = w; } }
}

#define WSB(off) ((bf16_t*)(a.ws + (off)))
#define us WSB(WS_US)
#define WinT WSB(WS_WIN)
#define WupT WSB(WS_WUP)
#define WdownT WSB(WS_WDOWN)
#define WoutT WSB(WS_WOUT)
#define WpgT WSB(WS_WPG)
#define WpaT WSB(WS_WPA)
#define WpbT WSB(WS_WPB)
#define WgluT WSB(WS_WGLU)
#define WpleT WSB(WS_WPLE)
#define pl WSB(WS_PL)
#define xb WSB(WS_XB)
#define ya WSB(WS_XB)
#define mg WSB(WS_XB)
#define x1b WSB(WS_XB)
#define Sbuf ((float*)(a.ws + WS_S))
#define ga WSB(WS_GA)
#define gb WSB(WS_GB)
#define yab WSB(WS_YAB)
#define A2 WSB(WS_A2)
#define pb WSB(WS_PB)
#define hb WSB(WS_HB)
#define BtS WSB(WS_BTS)
#define MM WSB(WS_MM)
#define ub ((bf16_t*)a.out)
#define vpre ((bf16_t*)a.out + (size_t)T * 512)
#define ybuf (a.out + O_Y)
__global__ void __launch_bounds__(512, 2) s5_gmlp_fwd(Args a) {
    extern __shared__ __attribute__((aligned(16))) unsigned char lds_raw[];
    LAS unsigned char* lds = (LAS unsigned char*)lds_raw;
    const int tid = threadIdx.x, lane = tid & 63, wid = __builtin_amdgcn_readfirstlane(tid >> 6), fr = lane & 15, fq = lane >> 4;
    const int G = gridDim.x, bx = blockIdx.x, gw = bx * 8 + wid, NGW = G * 8;
    const int lo = a.ph_lo, hi = a.ph_hi;
#ifdef PH_ONLY
#define IN(k) ((k) == PH_ONLY && lo <= (k) && (k) < hi)
#else
#define IN(k) (lo <= (k) && (k) < hi)
#endif
#define SEAM(k) do { if (IN(k) && IN((k) + 1)) xcd_barrier(xbar); } while (0)
    cg::grid_group grid = cg::this_grid();
    if (tid < 2) ((volatile LAS unsigned*)(lds + LDS_BARST))[tid] = 0u;
    if (bx == 0) for (int i = tid; i < (int)(BAR_BYTES / 4); i += 512) ((unsigned*)(a.ws + WS_BAR))[i] = 0u;
    __syncthreads();
    XcdBarrier xbar; xbar.bar = (unsigned*)(a.ws + WS_BAR); xbar.x = 0; xbar.st = (volatile LAS unsigned*)(lds + LDS_BARST);

    if (IN(0)) {
        {
            LAS float* scr = (LAS float*)(lds + wid * 16384);
            constexpr int I0 = 16 * 112, I1 = 8 * 16, I2 = 8 * 32, I3 = 8 * 32, I4 = 16 * 32, I5 = 16 * 128, I6 = 64 * 32, I7 = 4 * 32, I8 = 16 * 32;
            constexpr int NIT = I0 + I1 + I2 + I3 + I4 + I5 + I6 + I7 + I8;
            for (int it = gw; it < NIT; it += NGW) {
                int r = it;
                if (r < I0) { p0_transpose_item(a.in[6], 1024, INC, WinT, scr, r, lane); continue; } r -= I0;
                if (r < I1) { p0_transpose_item(a.in[16], 512, 512, WgluT, scr, r, lane); continue; } r -= I1;
                if (r < I2) { p0_transpose_item(a.in[22], 512, 1024, WpaT, scr, r, lane, 1024, 0); continue; } r -= I2;
                if (r < I3) { p0_transpose_item(a.in[23], 512, 1024, WpaT, scr, r, lane, 1024, 512); continue; } r -= I3;
                if (r < I4) { p0_transpose_item(a.in[24], 1024, 1024, WoutT, scr, r, lane); continue; } r -= I4;
                if (r < I5) { p0_transpose_item(a.in[28], 1024, DFF, WupT, scr, r, lane); continue; } r -= I5;
                if (r < I6) { p0_transpose_item(a.in[30], DFF, 1024, WdownT, scr, r, lane); continue; } r -= I6;
                if (r < I7) { p0_transpose_item(a.in[32], PLE, 1024, WpleT, scr, r, lane); continue; } r -= I7;
                p0_transpose_item(a.in[33], 1024, 1024, WpgT, scr, r, lane);
            }
        }
        __syncthreads();
        for (int it = bx; it < 256; it += G) { ssm_prep_block(a, lds, it & 31, it >> 5, tid, BtS, MM); __syncthreads(); }
        {
            const size_t i0 = (size_t)bx * 512 + tid, st = (size_t)G * 512;
            cvt_rows(a.in[0], xb, (size_t)NPT * 1024 / 8, i0, st); cvt_rows(a.in[1], xb + (size_t)NPT * 1024, (size_t)NST * 1024 / 8, i0, st);
            cvt_rows(a.in[4], pb, (size_t)NPT * 256 / 8, i0, st); cvt_rows(a.in[5], pb + (size_t)NPT * 256, (size_t)NST * 256 / 8, i0, st);
        }
    }
    if (IN(0) && IN(1)) { grid.sync(); xbar = xcd_barrier_post((unsigned*)(a.ws + WS_BAR), (volatile LAS unsigned*)(lds + LDS_BARST)); }

    if (IN(1)) {
        EpiZ Ez{a.in[7], A2, us, ub, vpre, ga, gb};
        { pg8::Gemm g{xb, WinT, 1024, 1024, 1024, 0, 0}; pg8::Order S; S.init(64, INC / 256, 1, G, bx); pg8::gemm_phase<EpiZ, true, true>(lds, g, S, Ez); }
        EpiPlain Ep{pl, 1024};
        { pg8::Gemm g{pb, WpleT, 256, 256, 256, 0, 0}; pg8::Order S; const int h = G / 2; S.init(64, 4, 1, h, bx >= h ? bx - h : -1); pg8::gemm_phase<EpiPlain, true, true>(lds, g, S, Ep); }
        __syncthreads();
        small_gemm(lds, xb + (size_t)NPT * 1024, 1024, WinT, 1024, INC, 1024, NPT, Ez);
        small_gemm(lds, pb + (size_t)NPT * 256, 256, WpleT, 256, 1024, 256, NPT, Ep);
    }
    SEAM(1);

    if (IN(2)) {
        const float* lng = a.in[18]; const float* lnb = a.in[19]; const float* sw = a.in[20]; const float* sbias = a.in[21];
        LAS float* st = (LAS float*)lds; LAS bf16_t* vT = (LAS bf16_t*)(lds + 1024);
        for (int un = bx; un < 512; un += G) {
            const int h = un & 3, row0 = (un >> 2) * 128;
            for (int rr = 0; rr < 16; ++rr) { const int r = wid * 16 + rr; f32x4 x0, x1; unpack8(*(const u32x4*)(vpre + (size_t)(row0 + r) * 512 + lane * 8), x0, x1);
                const float mean = wave_sum((x0[0] + x0[1]) + (x0[2] + x0[3]) + (x1[0] + x1[1]) + (x1[2] + x1[3])) * (1.f / 512.f);
                x0 = x0 - mean; x1 = x1 - mean;
                const float var = wave_sum((x0[0] * x0[0] + x0[1] * x0[1]) + (x0[2] * x0[2] + x0[3] * x0[3]) + (x1[0] * x1[0] + x1[1] * x1[1]) + (x1[2] * x1[2] + x1[3] * x1[3])) * (1.f / 512.f);
                if (lane == 0) { st[2 * r] = mean; st[2 * r + 1] = 1.0f / sqrtf(var + LN_EPS); } }
            __syncthreads();
#pragma unroll
            for (int i = 0; i < 2; ++i) { const int idx = tid + i * 512, s = (idx >> 4) * 2, dc = idx & 15, d0 = h * 128 + dc * 8;
                f32x4 x0, x1, y0, y1; unpack8(*(const u32x4*)(vpre + (size_t)(row0 + s) * 512 + d0), x0, x1); unpack8(*(const u32x4*)(vpre + (size_t)(row0 + s + 1) * 512 + d0), y0, y1);
                const float m0 = st[2 * s], r0 = st[2 * s + 1], m1 = st[2 * s + 2], r1 = st[2 * s + 3];
                const f32x4 g0 = *(const f32x4*)(lng + d0), g1 = *(const f32x4*)(lng + d0 + 4), b0 = *(const f32x4*)(lnb + d0), b1 = *(const f32x4*)(lnb + d0 + 4);
                x0 = (x0 - m0) * r0 * g0 + b0; x1 = (x1 - m0) * r0 * g1 + b1; y0 = (y0 - m1) * r1 * g0 + b0; y1 = (y1 - m1) * r1 * g1 + b1;
                LAS unsigned* q = (LAS unsigned*)(vT + (dc * 8) * 136 + s);
#pragma unroll
                for (int j = 0; j < 4; ++j) { q[j * 68] = cvt_pk_bf16(x0[j], y0[j]); q[(4 + j) * 68] = cvt_pk_bf16(x1[j], y1[j]); } }
            __syncthreads();
            f32x4 acc[4][2];
#pragma unroll
            for (int dg = 0; dg < 4; ++dg) { acc[dg][0] = (f32x4){0.f, 0.f, 0.f, 0.f}; acc[dg][1] = (f32x4){0.f, 0.f, 0.f, 0.f}; }
            const int t = wid * 16 + fr, nks = (wid >> 1) + 1;
            for (int ks = 0; ks < nks; ++ks) { const int s0 = ks * 32 + 8 * fq; const float* wp = sw + ((size_t)h * 128 + t) * 128 + s0;
                f32x4 w0 = *(const f32x4*)wp, w1 = *(const f32x4*)(wp + 4);
#pragma unroll
                for (int j = 0; j < 4; ++j) { if (s0 + j > t) w0[j] = 0.f; if (s0 + 4 + j > t) w1[j] = 0.f; }
                const u32x4 wpk = pack8(w0, w1); const bf16x8 wf = __builtin_bit_cast(bf16x8, wpk);
#pragma unroll
                for (int dg = 0; dg < 4; ++dg)
#pragma unroll
                    for (int n = 0; n < 2; ++n) { const bf16x8 vf = *(const LAS bf16x8*)(vT + (dg * 32 + pg8::perm32(16 * n + fr)) * 136 + s0);
                        acc[dg][n] = __builtin_amdgcn_mfma_f32_16x16x32_bf16(vf, wf, acc[dg][n], 0, 0, 0); } }
            { const float bs = sbias[h * 128 + t]; const size_t row = (size_t)row0 + t;
#pragma unroll
              for (int dg = 0; dg < 4; ++dg) { const int d = h * 128 + dg * 32 + 8 * fq; f32x4 u0, u1; unpack8(*(const u32x4*)(ub + row * 512 + d), u0, u1);
                  *(u32x4*)(yab + row * 1024 + 512 + d) = pack8(u0 * (acc[dg][0] + bs), u1 * (acc[dg][1] + bs)); } }
            __syncthreads();
        }
        for (int wt = gw; wt < 4096; wt += NGW) { const int g = wt >> 7, r = wt & 127, mt = r >> 2, ntl = r & 3;
            const bf16_t* ap = A2 + ((size_t)g * NR + mt * 16 + fr) * KS5 + 8 * fq;
            const bf16_t* b0 = MM + ((size_t)g * 128 + ntl * 32 + pg8::perm32(fr)) * 512 + 8 * fq; const bf16_t* b1 = MM + ((size_t)g * 128 + ntl * 32 + pg8::perm32(16 + fr)) * 512 + 8 * fq;
            f32x4 acc0 = {0.f, 0.f, 0.f, 0.f}, acc1 = {0.f, 0.f, 0.f, 0.f};
#pragma unroll 4
            for (int k = 0; k < 512; k += 32) { const bf16x8 av = *(const bf16x8*)(ap + k), w0 = *(const bf16x8*)(b0 + k), w1 = *(const bf16x8*)(b1 + k);
                acc0 = __builtin_amdgcn_mfma_f32_16x16x32_bf16(w0, av, acc0, 0, 0, 0); acc1 = __builtin_amdgcn_mfma_f32_16x16x32_bf16(w1, av, acc1, 0, 0, 0); }
            float* o = Sbuf + ((size_t)(mt * 16 + fr) * 32 + g) * 128 + ntl * 32 + 8 * fq; *(f32x4*)o = acc0; *(f32x4*)(o + 4) = acc1; }
        for (int wt = gw; wt < NST * SG; wt += NGW) { const int b = wt >> 5, g = wt & 31, p = lane;
            const float dt = expf(a.in[10][g]), lr = a.in[8][g * 64 + p], li = a.in[9][g * 64 + p];
            const float mag = expf(lr * dt), abr = mag * cosf(li * dt), abi = mag * sinf(li * dt);
            const float den = lr * lr + li * li, nr = abr - 1.0f, ni = abi, cor = (nr * lr + ni * li) / den, coi = (ni * lr - nr * li) / den;
            f32x4 u0, u1, u2, u3; unpack8(*(const u32x4*)(us + (size_t)b * 512 + g * 16), u0, u1); unpack8(*(const u32x4*)(us + (size_t)b * 512 + g * 16 + 8), u2, u3);
            const float* br = a.in[11] + ((size_t)g * 64 + p) * 16; const float* bi = a.in[12] + ((size_t)g * 64 + p) * 16;
            const f32x4 r0 = *(const f32x4*)br, r1 = *(const f32x4*)(br + 4), r2 = *(const f32x4*)(br + 8), r3 = *(const f32x4*)(br + 12);
            const f32x4 i0 = *(const f32x4*)bi, i1 = *(const f32x4*)(bi + 4), i2 = *(const f32x4*)(bi + 8), i3 = *(const f32x4*)(bi + 12);
            const f32x4 tr = r0 * u0 + r1 * u1 + r2 * u2 + r3 * u3, ti = i0 * u0 + i1 * u1 + i2 * u2 + i3 * u3;
            const float sr = (tr[0] + tr[1]) + (tr[2] + tr[3]), si = (ti[0] + ti[1]) + (ti[2] + ti[3]);
            const float h0r = a.in[2][((size_t)b * 32 + g) * 64 + p], h0i = a.in[3][((size_t)b * 32 + g) * 64 + p];
            const float hr = abr * h0r - abi * h0i + (cor * sr - coi * si), hi_ = abr * h0i + abi * h0r + (cor * si + coi * sr);
            a.out[O_SRE + ((size_t)b * 32 + g) * 64 + p] = hr; a.out[O_SIM + ((size_t)b * 32 + g) * 64 + p] = hi_;
            float yv = 0.f; const float uu[16] = {u0[0], u0[1], u0[2], u0[3], u1[0], u1[1], u1[2], u1[3], u2[0], u2[1], u2[2], u2[3], u3[0], u3[1], u3[2], u3[3]};
#pragma unroll
            for (int c = 0; c < 16; ++c) { const float part = a.in[13][((size_t)g * 16 + c) * 64 + p] * hr - a.in[14][((size_t)g * 16 + c) * 64 + p] * hi_;
                const float tot = wave_sum(part) + a.in[15][g * 16 + c] * uu[c]; yv = (lane == c) ? tot : yv; }
            { const float ge = gelu_tanh(yv), gn = __shfl_down(ge, 1); if (lane < 16 && !(lane & 1)) *(unsigned*)(ya + ((size_t)NPT + b) * 512 + g * 16 + lane) = cvt_pk_bf16(ge, gn); }
        }
        for (int b = gw; b < NST; b += NGW) { const size_t row = (size_t)NPT + b; f32x4 x0, x1; unpack8(*(const u32x4*)(vpre + row * 512 + lane * 8), x0, x1);
            const float mean = wave_sum((x0[0] + x0[1]) + (x0[2] + x0[3]) + (x1[0] + x1[1]) + (x1[2] + x1[3])) * (1.f / 512.f);
            x0 = x0 - mean; x1 = x1 - mean;
            const float var = wave_sum((x0[0] * x0[0] + x0[1] * x0[1]) + (x0[2] * x0[2] + x0[3] * x0[3]) + (x1[0] * x1[0] + x1[1] * x1[1]) + (x1[2] * x1[2] + x1[3] * x1[3])) * (1.f / 512.f);
            const float rstd = 1.0f / sqrtf(var + LN_EPS); const int d0 = lane * 8, h = lane >> 4;
            x0 = x0 * rstd * *(const f32x4*)(lng + d0) + *(const f32x4*)(lnb + d0); x1 = x1 * rstd * *(const f32x4*)(lng + d0 + 4) + *(const f32x4*)(lnb + d0 + 4);
            *(f32x4*)(a.out + O_SV + (size_t)b * 512 + d0) = x0; *(f32x4*)(a.out + O_SV + (size_t)b * 512 + d0 + 4) = x1;
            const float w00 = sw[(size_t)h * 128 * 128], b0 = sbias[h * 128]; f32x4 u0, u1; unpack8(*(const u32x4*)(ub + row * 512 + d0), u0, u1);
            *(u32x4*)(yab + row * 1024 + 512 + d0) = pack8(u0 * (x0 * w00 + b0), u1 * (x1 * w00 + b0)); }
    }
    SEAM(2);

    if (IN(3)) {
        LAS float* ex = (LAS float*)lds;
        for (int pair = bx; pair < NBATCH * SG; pair += G) { const int b = pair >> 5, g = pair & 31, p = lane, sg = wid;
            float ar = 0.f, ai = 0.f, hr = 0.f, hi_ = 0.f; f32x2 loc[16];
            if (wid < 4) {
                const float dt = expf(a.in[10][g]), lr = a.in[8][g * 64 + p], li = a.in[9][g * 64 + p];
                const float m32 = expf(32.f * lr * dt); ar = m32 * cosf(32.f * li * dt); ai = m32 * sinf(32.f * li * dt);
                f32x2 sv[16];
#pragma unroll
                for (int i = 0; i < 16; ++i) sv[i] = *(const f32x2*)(Sbuf + ((size_t)(b * NCHUNK + sg * 16 + i) * 32 + g) * 128 + 2 * p);
#pragma unroll
                for (int i = 0; i < 16; ++i) { loc[i] = (f32x2){hr, hi_}; const float nr = ar * hr - ai * hi_ + sv[i][0], ni = ar * hi_ + ai * hr + sv[i][1]; hr = nr; hi_ = ni; }
                ex[(sg * 64 + p) * 2] = hr; ex[(sg * 64 + p) * 2 + 1] = hi_;
            }
            __syncthreads();
            if (wid < 4) {
                float qr = ar, qi = ai;
#pragma unroll
                for (int i = 0; i < 4; ++i) { const float t0 = qr * qr - qi * qi, t1 = 2.f * qr * qi; qr = t0; qi = t1; }
                float cr = 0.f, ci = 0.f;
                for (int s2 = 0; s2 < sg; ++s2) { const float er = ex[(s2 * 64 + p) * 2], ei = ex[(s2 * 64 + p) * 2 + 1]; const float t0 = qr * cr - qi * ci + er, t1 = qr * ci + qi * cr + ei; cr = t0; ci = t1; }
                float pr = 1.f, pi_ = 0.f;
#pragma unroll
                for (int i = 0; i < 16; ++i) { const float Hr = loc[i][0] + pr * cr - pi_ * ci, Hi = loc[i][1] + pr * ci + pi_ * cr;
                    *(unsigned*)(A2 + ((size_t)g * NR + b * NCHUNK + sg * 16 + i) * KS5 + 512 + 2 * p) = cvt_pk_bf16(Hr, Hi);
                    const float t0 = pr * ar - pi_ * ai, t1 = pr * ai + pi_ * ar; pr = t0; pi_ = t1; }
                if (sg == 3) { a.out[O_PRE + ((size_t)b * 32 + g) * 64 + p] = hr + pr * cr - pi_ * ci; a.out[O_PIM + ((size_t)b * 32 + g) * 64 + p] = hi_ + pr * ci + pi_ * cr; }
            }
            __syncthreads();
        }
    }
    SEAM(3);

    if (IN(4)) {
        EpiS5 E{ya};
        pg8::Gemm g{A2, BtS, KS5, KS5, KS5, (size_t)NR * KS5 * 2, (size_t)512 * KS5 * 2}; pg8::Order S; S.init(2, 2, SG, G, bx); pg8::gemm_phase<EpiS5, true, true>(lds, g, S, E);
    }
    SEAM(4);

    if (IN(5)) {
        EpiGlu E{a.in[17], ya, yab};
        { pg8::Gemm g{ya, WgluT, 512, 512, 512, 0, 0}; pg8::Order S; S.init(64, 2, 1, G, bx); pg8::gemm_phase<EpiGlu, true, true>(lds, g, S, E); }
        __syncthreads();
        small_gemm(lds, ya + (size_t)NPT * 512, 512, WgluT, 512, 512, 512, NPT, E);
    }
    SEAM(5);

    if (IN(6)) {
        EpiMerge E{ga, gb, mg};
        { pg8::Gemm g{yab, WpaT, 1024, 1024, 1024, 0, 0}; pg8::Order S; S.init(64, 4, 1, G, bx); pg8::gemm_phase<EpiMerge, true, true>(lds, g, S, E); }
        __syncthreads();
        small_gemm(lds, yab + (size_t)NPT * 1024, 1024, WpaT, 1024, 1024, 1024, NPT, E);
    }
    SEAM(6);

    if (IN(7)) {
        EpiOut E{a.in[25], a.in[0], a.in[1], ybuf};
        { pg8::Gemm g{mg, WoutT, 1024, 1024, 1024, 0, 0}; pg8::Order S; S.init(64, 4, 1, G, bx); pg8::gemm_phase<EpiOut, true, true>(lds, g, S, E); }
        __syncthreads();
        small_gemm(lds, mg + (size_t)NPT * 1024, 1024, WoutT, 1024, 1024, 1024, NPT, E);
    }
    SEAM(7);

    if (IN(8)) { for (int r = gw; r < T; r += NGW) ln_row(ybuf + (size_t)r * 1024, a.in[26], a.in[27], x1b + (size_t)r * 1024, lane); }
    SEAM(8);

    if (IN(9)) {
        EpiUp Eu{a.in[29], hb}; EpiPg Eg{a.in[34], pl};
        { pg8::Gemm g{x1b, WupT, 1024, 1024, 1024, 0, 0}; pg8::Order S; S.init(64, 16, 1, G, bx); pg8::gemm_phase<EpiUp, true, true>(lds, g, S, Eu); }
        { pg8::Gemm g{x1b, WpgT, 1024, 1024, 1024, 0, 0}; pg8::Order S; S.init(64, 4, 1, G, bx); pg8::gemm_phase<EpiPg, true, true>(lds, g, S, Eg); }
        __syncthreads();
        small_gemm(lds, x1b + (size_t)NPT * 1024, 1024, WupT, 1024, DFF, 1024, NPT, Eu);
        small_gemm(lds, x1b + (size_t)NPT * 1024, 1024, WpgT, 1024, 1024, 1024, NPT, Eg);
    }
    SEAM(9);

    if (IN(10)) {
        EpiDown E{a.in[31], pl, ybuf};
        { pg8::Gemm g{hb, WdownT, DFF, DFF, DFF, 0, 0}; pg8::Order S; S.init(64, 4, 1, G, bx); pg8::gemm_phase<EpiDown, true, true>(lds, g, S, E); }
        __syncthreads();
        small_gemm(lds, hb + (size_t)NPT * DFF, DFF, WdownT, DFF, 1024, DFF, NPT, E);
    }
    SEAM(10);

    if (IN(11)) { for (int r = gw; r < T; r += NGW) ln_row(ybuf + (size_t)r * 1024, a.in[35], a.in[36], nullptr, lane); }
#ifdef DBG_K
    xcd_barrier(xbar);
    {   const size_t n = (size_t)T * 1024; const size_t tot = O_SV + 65536;
        for (size_t i = (size_t)bx * 512 + tid; i < tot; i += (size_t)G * 512) { float v = 0.f;
            if (i < n) { DBG_EXPR } a.out[i] = v; } }
#endif
#undef IN
#undef SEAM
}

#undef WSB
#undef us
#undef WinT
#undef WupT
#undef WdownT
#undef WoutT
#undef WpgT
#undef WpaT
#undef WpbT
#undef WgluT
#undef WpleT
#undef pl
#undef xb
#undef ya
#undef mg
#undef x1b
#undef Sbuf
#undef ga
#undef gb
#undef yab
#undef A2
#undef pb
#undef hb
#undef BtS
#undef MM
#undef ub
#undef vpre
#undef ybuf
#ifndef MK_PER_PHASE
#define MK_PER_PHASE 0
#endif
extern "C" void kernel_launch(void* const* d_in, const int* in_sizes, int n_in, void* d_out, int out_size, void* d_ws, size_t ws_size, hipStream_t stream) {
    static int grid = 0;
    if (grid == 0) {
        if (n_in != 37 || ws_size < WS_END) { fprintf(stderr, "kernel_launch: unexpected n_in %d / ws %zu\n", n_in, ws_size); grid = -1; return; }
        int dev = 0, cus = 0, per_cu = 0;
        hipGetDevice(&dev); hipDeviceGetAttribute(&cus, hipDeviceAttributeMultiprocessorCount, dev);
        if (hipFuncSetAttribute((const void*)s5_gmlp_fwd, hipFuncAttributeMaxDynamicSharedMemorySize, LDS_BYTES) != hipSuccess) { fprintf(stderr, "kernel_launch: hipFuncSetAttribute failed\n"); grid = -1; return; }
        if (hipOccupancyMaxActiveBlocksPerMultiprocessor(&per_cu, (const void*)s5_gmlp_fwd, 512, LDS_BYTES) != hipSuccess || per_cu < 1) { fprintf(stderr, "kernel_launch: occupancy query says %d\n", per_cu); per_cu = 1; }
        (void)hipGetLastError();
        grid = cus;
    }
    if (grid < 0) return;
    Args a{};
    for (int i = 0; i < 37; ++i) a.in[i] = (const float*)d_in[i];
    a.out = (float*)d_out; a.ws = (unsigned char*)d_ws;
#if MK_PER_PHASE
    for (int ph = 0; ph < 12; ++ph) { a.ph_lo = ph; a.ph_hi = ph + 1; void* args[] = {&a};
        hipError_t e = hipLaunchCooperativeKernel((const void*)s5_gmlp_fwd, dim3(grid), dim3(512), args, LDS_BYTES, stream);
        if (e != hipSuccess) { fprintf(stderr, "launch failed: %s\n", hipGetErrorString(e)); break; } }
#else
#ifdef DBG_K
    a.ph_lo = 0; a.ph_hi = DBG_K + 1; void* args[] = {&a};
#else
#ifdef PROBE_PREFIX
    { a.ph_lo = 0; a.ph_hi = PROBE_PREFIX; void* pargs[] = {&a}; (void)hipLaunchCooperativeKernel((const void*)s5_gmlp_fwd, dim3(grid), dim3(512), pargs, LDS_BYTES, stream); }
#endif
    a.ph_lo = 0; a.ph_hi = 12; void* args[] = {&a};
#endif
    hipError_t e = hipLaunchCooperativeKernel((const void*)s5_gmlp_fwd, dim3(grid), dim3(512), args, LDS_BYTES, stream);
    if (e != hipSuccess) fprintf(stderr, "cooperative launch failed: %s (grid %d)\n", hipGetErrorString(e), grid);
#endif
}
```
